# Optimizing an MI355X kernel written in HIP

```python
import functools
import jax, jax.numpy as jnp
from jax import lax
import numpy as np

D_MODEL = 1024
BATCH = 8
SEQ = 2048
DEPTH = 4
DEC_BATCH = 128
DEC_SEQ = 1
PAST_LEN = 8192
PAGE_SIZE = 128

N_A_LAYERS = DEPTH // 2
N_B_LAYERS = DEPTH - N_A_LAYERS
CHUNK = 128
D_SGU = 2 * D_MODEL
SGU_GROUPS = 8
SGU_GROUP_DIM = D_SGU // SGU_GROUPS
N_HEADS = 16
QK_NOPE_DIM = 128
QK_ROPE_DIM = 64
V_HEAD_DIM = 128
Q_LORA_RANK = 384
KV_LORA_RANK = 256
ROPE_THETA = 10000.0
D_FF = -(-8 * D_MODEL // (3 * 256)) * 256
ATTN_SCALE = (QK_NOPE_DIM + QK_ROPE_DIM) ** -0.5
EPS = 1e-6
Q_BLOCK = 128

kernel_name = "yoco_chunk_sgu_mla_decoder_step"


def rmsnorm(x, g):
    xf = x.astype(jnp.float32)
    y = xf * lax.rsqrt(jnp.mean(xf * xf, axis=-1, keepdims=True) + EPS)
    return (y * g.astype(jnp.float32)).astype(x.dtype)


def rope(x, pos):
    inv = ROPE_THETA ** (-jnp.arange(0, QK_ROPE_DIM, 2, dtype=jnp.float32) / QK_ROPE_DIM)
    ang = pos[:, None] * inv[None, :]
    ang = ang.reshape((ang.shape[0],) + (1,) * (x.ndim - 3) + (ang.shape[1],))
    cos, sin = jnp.cos(ang), jnp.sin(ang)
    x1, x2 = jnp.split(x.astype(jnp.float32), 2, axis=-1)
    return jnp.concatenate([x1 * cos - x2 * sin, x2 * cos + x1 * sin], axis=-1).astype(x.dtype)


def swiglu(h, w_in, w_out):
    g, u = jnp.split(h @ w_in, 2, axis=-1)
    return (jax.nn.silu(g) * u) @ w_out


def chunk_sgu(h, w_in, v_norm, w_s, b_s, w_out):
    z = jax.nn.gelu(h @ w_in)
    u, v = jnp.split(z, 2, axis=-1)
    v = rmsnorm(v, v_norm)
    B, L, _ = v.shape
    Lp = -(-L // CHUNK) * CHUNK
    vp = jnp.pad(v, ((0, 0), (0, Lp - L), (0, 0)))
    vc = vp.reshape(B, Lp // CHUNK, CHUNK, SGU_GROUPS, SGU_GROUP_DIM)
    ws = w_s * jnp.tril(jnp.ones((CHUNK, CHUNK), dtype=w_s.dtype))
    mixed = jnp.einsum('gts,bcsgd->bctgd', ws, vc) + jnp.transpose(b_s)[:, :, None]
    mixed = mixed.reshape(B, Lp, D_SGU)[:, :L]
    return (u * mixed) @ w_out, v


def shared_kv(h, norm_g, w_dkv, lat_norm, pos):
    ckr = rmsnorm(h, norm_g) @ w_dkv
    c = rmsnorm(ckr[..., :KV_LORA_RANK], lat_norm)
    kr = rope(ckr[..., KV_LORA_RANK:], pos)
    return c, kr


def mla_query(hn, w_dq, q_norm, w_uq, w_uk, pos):
    B, L, _ = hn.shape
    cq = rmsnorm(hn @ w_dq, q_norm)
    q = (cq @ w_uq).reshape(B, L, N_HEADS, QK_NOPE_DIM + QK_ROPE_DIM)
    q_nope, q_rope = q[..., :QK_NOPE_DIM], q[..., QK_NOPE_DIM:]
    q_rope = rope(q_rope, pos)
    q_lat = jnp.einsum('blhd,chd->blhc', q_nope, w_uk)
    return q_lat, q_rope


def attend_prompt(q_lat, q_rope, c, kr):
    B, L = q_lat.shape[:2]
    qb = min(Q_BLOCK, L)
    nb = L // qb
    ql = q_lat.reshape(B, nb, qb, N_HEADS, KV_LORA_RANK).transpose(1, 0, 2, 3, 4)
    qr = q_rope.reshape(B, nb, qb, N_HEADS, QK_ROPE_DIM).transpose(1, 0, 2, 3, 4)
    kpos = jnp.arange(L)

    def block(args):
        i, qlb, qrb = args
        s = (jnp.einsum('bqhc,bkc->bhqk', qlb, c, preferred_element_type=jnp.float32)
             + jnp.einsum('bqhr,bkr->bhqk', qrb, kr, preferred_element_type=jnp.float32)) * ATTN_SCALE
        qpos = i * qb + jnp.arange(qb)
        s = jnp.where(kpos[None, :] <= qpos[:, None], s, -jnp.inf)
        p = jax.nn.softmax(s, axis=-1).astype(c.dtype)
        return jnp.einsum('bhqk,bkc->bqhc', p, c)

    o = lax.map(block, (jnp.arange(nb), ql, qr))
    return o.transpose(1, 0, 2, 3, 4).reshape(B, L, N_HEADS, KV_LORA_RANK)


def attend_sample(q_lat, q_rope, c_new, kr_new, c_past, kr_past):
    s_past = (jnp.einsum('bqhc,bkc->bhqk', q_lat, c_past, preferred_element_type=jnp.float32)
              + jnp.einsum('bqhr,bkr->bhqk', q_rope, kr_past, preferred_element_type=jnp.float32))
    s_new = (jnp.einsum('bqhc,bkc->bhqk', q_lat, c_new, preferred_element_type=jnp.float32)
             + jnp.einsum('bqhr,bkr->bhqk', q_rope, kr_new, preferred_element_type=jnp.float32))
    n = c_new.shape[1]
    s_new = jnp.where(jnp.tril(jnp.ones((n, n), dtype=bool)), s_new, -jnp.inf)
    s = jnp.concatenate([s_past, s_new], axis=-1) * ATTN_SCALE
    p = jax.nn.softmax(s, axis=-1).astype(c_new.dtype)
    P = c_past.shape[1]
    return (jnp.einsum('bhqk,bkc->bqhc', p[..., :P], c_past)
            + jnp.einsum('bhqk,bkc->bqhc', p[..., P:], c_new))


def trunk(x, pos, attend, norm_mix, sgu_w_in, sgu_v_norm, sgu_w_s, sgu_b_s, sgu_w_out,
          norm_ffn, ffn_w_in, ffn_w_out, kv_norm, w_dkv, kv_latent_norm, w_uk, w_uv,
          w_dq, q_norm, w_uq, w_o, final_norm):
    h = x
    v_rows = []
    c = kr = None
    for l in range(DEPTH):
        hn = rmsnorm(h, norm_mix[l])
        if l < N_A_LAYERS:
            a_out, v = chunk_sgu(hn, sgu_w_in[l], sgu_v_norm[l], sgu_w_s[l], sgu_b_s[l], sgu_w_out[l])
            h = h + a_out
            v_rows.append(v)
        else:
            j = l - N_A_LAYERS
            q_lat, q_rope = mla_query(hn, w_dq[j], q_norm[j], w_uq[j], w_uk, pos)
            o_lat = attend(q_lat, q_rope, c, kr)
            o = jnp.einsum('blhc,chv->blhv', o_lat, w_uv)
            h = h + o.reshape(o.shape[0], o.shape[1], N_HEADS * V_HEAD_DIM) @ w_o[j]
        h = h + swiglu(rmsnorm(h, norm_ffn[l]), ffn_w_in[l], ffn_w_out[l])
        if l == N_A_LAYERS - 1:
            c, kr = shared_kv(h, kv_norm, w_dkv, kv_latent_norm, pos)
    return rmsnorm(h, final_norm), c, kr, jnp.stack(v_rows)


def setup_inputs(seed: int = 0) -> dict:
    key = jax.random.key(seed)
    ks = jax.random.split(key, 26)
    f32 = jnp.float32

    def w(k, shape, fan_in):
        return jax.random.normal(k, shape, f32) * fan_in ** -0.5

    def gain(k, shape):
        return 1.0 + 0.05 * jax.random.normal(k, shape, f32)

    n_pages = PAST_LEN // PAGE_SIZE
    n_used = DEC_BATCH * n_pages
    n_phys = n_used + max(1, n_used // 4)
    perm = jax.random.permutation(ks[3], n_phys)[:n_used]
    page_table = perm.reshape(DEC_BATCH, n_pages).astype(jnp.int32)

    return {
        "x_prompt": jax.random.normal(ks[0], (BATCH, SEQ, D_MODEL), f32),
        "x_sample": jax.random.normal(ks[1], (DEC_BATCH, DEC_SEQ, D_MODEL), f32),
        "cache_kv_latent": jax.random.normal(ks[2], (n_phys, PAGE_SIZE, KV_LORA_RANK), f32),
        "cache_k_rope": jax.random.normal(ks[4], (n_phys, PAGE_SIZE, QK_ROPE_DIM), f32),
        "page_table": page_table,
        "norm_mix": gain(ks[5], (DEPTH, D_MODEL)),
        "sgu_w_in": w(ks[6], (N_A_LAYERS, D_MODEL, 2 * D_SGU), D_MODEL),
        "sgu_v_norm": gain(ks[7], (N_A_LAYERS, D_SGU)),
        "sgu_w_s": 0.5 * w(ks[8], (N_A_LAYERS, SGU_GROUPS, CHUNK, CHUNK), CHUNK),
        "sgu_b_s": 1.0 + 0.1 * jax.random.normal(ks[9], (N_A_LAYERS, SGU_GROUPS, CHUNK), f32),
        "sgu_w_out": w(ks[10], (N_A_LAYERS, D_SGU, D_MODEL), D_SGU),
        "norm_ffn": gain(ks[11], (DEPTH, D_MODEL)),
        "ffn_w_in": w(ks[12], (DEPTH, D_MODEL, 2 * D_FF), D_MODEL),
        "ffn_w_out": w(ks[13], (DEPTH, D_FF, D_MODEL), D_FF),
        "kv_norm": gain(ks[14], (D_MODEL,)),
        "w_dkv": w(ks[15], (D_MODEL, KV_LORA_RANK + QK_ROPE_DIM), D_MODEL),
        "kv_latent_norm": gain(ks[16], (KV_LORA_RANK,)),
        "w_uk": w(ks[17], (KV_LORA_RANK, N_HEADS, QK_NOPE_DIM), KV_LORA_RANK),
        "w_uv": w(ks[18], (KV_LORA_RANK, N_HEADS, V_HEAD_DIM), KV_LORA_RANK),
        "w_dq": w(ks[19], (N_B_LAYERS, D_MODEL, Q_LORA_RANK), D_MODEL),
        "q_norm": gain(ks[20], (N_B_LAYERS, Q_LORA_RANK)),
        "w_uq": w(ks[21], (N_B_LAYERS, Q_LORA_RANK, N_HEADS * (QK_NOPE_DIM + QK_ROPE_DIM)), Q_LORA_RANK),
        "w_o": w(ks[22], (N_B_LAYERS, N_HEADS * V_HEAD_DIM, D_MODEL), N_HEADS * V_HEAD_DIM),
        "final_norm": gain(ks[23], (D_MODEL,)),
    }


def reference(x_prompt, x_sample, cache_kv_latent, cache_k_rope, page_table,
              norm_mix, sgu_w_in, sgu_v_norm, sgu_w_s, sgu_b_s, sgu_w_out,
              norm_ffn, ffn_w_in, ffn_w_out, kv_norm, w_dkv, kv_latent_norm, w_uk, w_uv,
              w_dq, q_norm, w_uq, w_o, final_norm):
    params = (norm_mix, sgu_w_in, sgu_v_norm, sgu_w_s, sgu_b_s, sgu_w_out,
              norm_ffn, ffn_w_in, ffn_w_out, kv_norm, w_dkv, kv_latent_norm, w_uk, w_uv,
              w_dq, q_norm, w_uq, w_o, final_norm)

    pos_p = jnp.arange(x_prompt.shape[1], dtype=jnp.float32)
    y_prompt, kv_latent_prompt, k_rope_prompt, _ = trunk(x_prompt, pos_p, attend_prompt, *params)

    n_seq, n_pages = page_table.shape
    c_past = cache_kv_latent[page_table].reshape(n_seq, n_pages * PAGE_SIZE, KV_LORA_RANK)
    kr_past = cache_k_rope[page_table].reshape(n_seq, n_pages * PAGE_SIZE, QK_ROPE_DIM)
    pos_s = jnp.arange(x_sample.shape[1], dtype=jnp.float32) + PAST_LEN
    attend_s = functools.partial(attend_sample, c_past=c_past, kr_past=kr_past)
    y_sample, kv_latent_sample, k_rope_sample, sgu_v_sample = trunk(x_sample, pos_s, attend_s, *params)

    return (y_prompt, y_sample, kv_latent_prompt, k_rope_prompt, kv_latent_sample, k_rope_sample, sgu_v_sample)
```

```cpp
#include <hip/hip_runtime.h>
#include <cstdio>
#include <cstdint>

#ifndef MK_LAUNCHES
#define MK_LAUNCHES 1
#endif

#define LAS __attribute__((address_space(3)))
typedef unsigned short bf16_t;
typedef short bf16x8 __attribute__((ext_vector_type(8)));
typedef short s16x4 __attribute__((ext_vector_type(4)));
typedef float f32x2 __attribute__((ext_vector_type(2)));
typedef float f32x4 __attribute__((ext_vector_type(4)));
typedef float f32x16 __attribute__((ext_vector_type(16)));
typedef unsigned u32x2 __attribute__((ext_vector_type(2)));
typedef unsigned u32x4 __attribute__((ext_vector_type(4)));

constexpr int D = 1024, MP = 16384, MS = 128, MT = MP + MS, NPAN = 65, MPAD = NPAN * 256;
constexpr int SEQ = 2048, DSGU = 2048, DFF = 2816, QLR = 384, NH = 16, KVC = 256, RD = 64, QKD = 320, NQ = NH * QKD;
constexpr int NPAGES = 64;
constexpr float EPS = 1e-6f;
constexpr float QSCALE = 0.10411754627697264f;
constexpr int LDS_BYTES = 153600;
constexpr int LDS_MISC = 152576;

constexpr size_t O_YP = 0, O_YS = 16777216, O_KLP = 16908288, O_KRP = 21102592, O_KLS = 22151168, O_KRS = 22183936, O_SGV = 22192128;

constexpr size_t al(size_t x) { return (x + 255) & ~size_t(255); }
constexpr int NSS = 14;
constexpr size_t WS_BAR = 0;
constexpr size_t WS_CNT = al(WS_BAR + 3456 * 4);
constexpr size_t WS_SS = al(WS_CNT + 2 * 128 * 4);
constexpr size_t WS_ZERO_END = al(WS_SS + (size_t)NSS * MPAD * 4);
constexpr size_t WS_ROPE = WS_ZERO_END;
constexpr size_t WS_W1 = al(WS_ROPE + 2049 * 32 * 8);
constexpr size_t WS_W3 = al(WS_W1 + (size_t)2 * 4096 * 1024 * 2);
constexpr size_t WS_W4 = al(WS_W3 + (size_t)2 * 1024 * 2048 * 2);
constexpr size_t WS_W5 = al(WS_W4 + (size_t)4 * 5632 * 1024 * 2);
constexpr size_t WS_WKVQ = al(WS_W5 + (size_t)4 * 1024 * 2816 * 2);
constexpr size_t WS_WDQ1 = al(WS_WKVQ + (size_t)768 * 1024 * 2);
constexpr size_t WS_WQ = al(WS_WDQ1 + (size_t)512 * 1024 * 2);
constexpr size_t WS_WUV = al(WS_WQ + (size_t)2 * 5120 * 384 * 2);
constexpr size_t WS_WO = al(WS_WUV + (size_t)2048 * 512 * 2);
constexpr size_t WS_UKP = al(WS_WO + (size_t)2 * 1024 * 2048 * 2);
constexpr size_t WS_UQP = al(WS_UKP + (size_t)16 * 256 * 256 * 2);
constexpr size_t WS_H = al(WS_UQP + (size_t)2 * 16 * 512 * 256 * 2);
constexpr size_t WS_HB = al(WS_H + (size_t)MPAD * 1024 * 4);
constexpr size_t WS_U = al(WS_HB + (size_t)MPAD * 1024 * 2);
constexpr size_t WS_V = al(WS_U + (size_t)MPAD * 2048 * 2);
constexpr size_t WS_F = al(WS_V + (size_t)MPAD * 2048 * 2);
constexpr size_t WS_CQ = al(WS_F + (size_t)MPAD * 2816 * 2);
constexpr size_t WS_QF = al(WS_CQ + (size_t)MPAD * 384 * 2);
constexpr size_t WS_KVR = al(WS_QF + (size_t)MPAD * 5120 * 2);
constexpr size_t WS_KVB = al(WS_KVR + (size_t)MPAD * 320 * 4);
constexpr size_t WS_OL = al(WS_KVB + (size_t)MPAD * 320 * 2);
constexpr size_t WS_OV = al(WS_OL + (size_t)MPAD * 4096 * 2);
constexpr size_t WS_PO = al(WS_OV + (size_t)MPAD * 2048 * 2);
constexpr size_t WS_PML = al(WS_PO + (size_t)256 * 16 * 256 * 4);
constexpr size_t WS_SLAB = al(WS_PML + 256 * 16 * 8);
constexpr size_t WS_SSP = al(WS_SLAB + (size_t)11 * MS * D * 4);
constexpr size_t WS_SLAB2 = al(WS_SSP + (size_t)MPAD * 32 * 4);
constexpr size_t WS_KC = al(WS_SLAB2 + (size_t)4 * MS * 4096 * 4);
constexpr size_t WS_QH = al(WS_KC + (size_t)256 * 8 * 32 * 10 * 1024);
constexpr size_t WS_KN = al(WS_QH + (size_t)MP * 3072 * 2);
constexpr size_t WS_VH = al(WS_KN + (size_t)MP * 2048 * 2);
constexpr size_t WS_WQS = al(WS_VH + (size_t)MP * 2048 * 2);
constexpr size_t WS_WKV2 = al(WS_WQS + (size_t)2 * 3072 * 384 * 2);
constexpr size_t WS_END = al(WS_WKV2 + (size_t)4096 * 256 * 2);

__device__ __forceinline__ unsigned cvt_pk_bf16(float lo, float hi) { unsigned r; asm volatile("v_cvt_pk_bf16_f32 %0, %1, %2" : "=v"(r) : "v"(lo), "v"(hi)); return r; }
__device__ __forceinline__ float bf_lo(unsigned w) { return __uint_as_float(w << 16); }
__device__ __forceinline__ float bf_hi(unsigned w) { return __uint_as_float(w & 0xffff0000u); }
__device__ __forceinline__ float fast_exp2(float x) { return __builtin_amdgcn_exp2f(x); }
__device__ __forceinline__ float fast_rcp(float x) { return __builtin_amdgcn_rcpf(x); }
__device__ __forceinline__ float gelu_tanh(float x) {
    const float t = x * (1.0f + 0.044715f * x * x);
    return x * fast_rcp(1.0f + fast_exp2(-2.302208198144325f * t));
}
__device__ __forceinline__ float silu_f(float x) { return x * fast_rcp(1.0f + fast_exp2(-1.4426950408889634f * x)); }
__device__ __forceinline__ void atomic_add_f32(float* p, float v) { unsafeAtomicAdd(p, v); }
__device__ __forceinline__ int opaque_tid(int wv) { unsigned z = 0u; asm volatile("" : "+v"(z)); int t = (wv << 6) + (int)__builtin_amdgcn_mbcnt_hi(~0u, __builtin_amdgcn_mbcnt_lo(~0u, z)); asm volatile("" : "+v"(t)); return t; }

#define XB_TMO      128
#define XB_XCNT(j)  (256  + 64 * (j))
#define XB_XSUB(j)  (1280 + 64 * (j))
#define XB_XGEN(j)  (2304 + 64 * (j))
#define XB_TOP      3328
#define XB_TOPGEN   3392
#define XCD_BAR_WORDS 3456
#define XB_SPIN_CAP (1u << 18)

__device__ __forceinline__ unsigned xb_ld(unsigned* p)              { return __hip_atomic_load(p, __ATOMIC_RELAXED, __HIP_MEMORY_SCOPE_AGENT); }
__device__ __forceinline__ unsigned xb_add(unsigned* p, unsigned v) { return __hip_atomic_fetch_add(p, v, __ATOMIC_RELAXED, __HIP_MEMORY_SCOPE_AGENT); }
__device__ __forceinline__ unsigned xb_xcc_id() { return (unsigned)__builtin_amdgcn_s_getreg((3 << 11) | 20) & 0xFu; }
#define XB_SPIN(cond, bar) do { unsigned _sp = 0; while (cond) { __builtin_amdgcn_s_sleep(1); \
    if ((++_sp & 255u) == 0u) { if (xb_ld(&(bar)[XB_TMO])) break; if (_sp > XB_SPIN_CAP) { atomicAdd(&(bar)[XB_TMO], 1u); break; } } } } while (0)

struct XcdBarrier { unsigned* bar; unsigned x; volatile LAS unsigned* st; };

__device__ __forceinline__ XcdBarrier xcd_barrier_post(unsigned* bar, volatile LAS unsigned* st) {
    XcdBarrier b; b.bar = bar; b.x = xb_xcc_id(); b.st = st;
    if (threadIdx.x == 0) (void)xb_add(&bar[XB_XCNT(b.x)], 1u);
    return b;
}
__device__ __forceinline__ void xcd_barrier_complete(unsigned* bar, unsigned x, unsigned& nloc, unsigned& nx) {
    const unsigned G = gridDim.x * gridDim.y * gridDim.z;
    unsigned sum, cnt, mine, sp = 0u;
    for (;;) {
        sum = 0u; cnt = 0u; mine = 0u;
#pragma unroll
        for (unsigned j = 0; j < 16; ++j) { const unsigned c = xb_ld(&bar[XB_XCNT(j)]); sum += c; cnt += (c > 0u) ? 1u : 0u; mine = (j == x) ? c : mine; }
        if (sum == G) break;
        __builtin_amdgcn_s_sleep(1);
        if ((++sp & 255u) == 0u) { if (xb_ld(&bar[XB_TMO])) break; if (sp > XB_SPIN_CAP) { atomicAdd(&bar[XB_TMO], 1u); break; } }
    }
    nloc = mine > 0u ? mine : 1u; nx = cnt > 0u ? cnt : 1u;
}
__device__ __forceinline__ void xcd_barrier(const XcdBarrier& b) {
    asm volatile("s_waitcnt vmcnt(0)" ::: "memory");
    __syncthreads();
    if (threadIdx.x == 0) {
        unsigned* bar = b.bar;
        __builtin_amdgcn_s_waitcnt(0);
        unsigned nloc = b.st[0], nx = b.st[1];
        if (nloc == 0u) { xcd_barrier_complete(bar, b.x, nloc, nx); b.st[0] = nloc; b.st[1] = nx; }
        const unsigned old = xb_add(&bar[XB_XSUB(b.x)], 1u);
        const unsigned gen = old / nloc;
        if (old + 1u == (gen + 1u) * nloc) {
            __builtin_amdgcn_fence(__ATOMIC_RELEASE, "agent");
            asm volatile("s_waitcnt vmcnt(0)" ::: "memory");
            const unsigned og = xb_add(&bar[XB_TOP], 1u);
            const unsigned tg = og / nx;
            if (og + 1u == (tg + 1u) * nx) xb_add(&bar[XB_TOPGEN], 1u);
            else XB_SPIN(xb_ld(&bar[XB_TOPGEN]) == tg, bar);
            __builtin_amdgcn_fence(__ATOMIC_ACQUIRE, "agent");
            xb_add(&bar[XB_XGEN(b.x)], 1u);
            asm volatile("s_waitcnt vmcnt(0)" ::: "memory");
        } else {
            XB_SPIN(xb_ld(&bar[XB_XGEN(b.x)]) == gen, bar);
            __builtin_amdgcn_fence(__ATOMIC_ACQUIRE, "agent");
            asm volatile("s_waitcnt vmcnt(0)" ::: "memory");
        }
    }
    __syncthreads();
}

namespace pg8 {
constexpr int BM = 256, BK = 64, HALF = 128, HTB = HALF * BK * 2, STAGE_BYTES = 8 * HTB, NXCD = 8, WGM = 8, NPAN_ = 65;
__host__ __device__ __forceinline__ int lds_byte(int r, int c) { const int st = (r >> 4) * 2 + (c >> 5), rr = r & 15, cc = c & 31, ob = rr * 64 + cc * 2; return st * 1024 + (ob ^ (((ob >> 9) & 1) << 5)); }
__host__ __device__ __forceinline__ void stage_rc(int b, int& R, int& C) { const int st = b / 1024, sb = b % 1024, swz = sb ^ (((sb >> 9) & 1) << 5); R = (st >> 1) * 16 + swz / 64; C = (st & 1) * 32 + (swz % 64) / 2; }
__host__ __device__ __forceinline__ int perm32(int rho) { const int n = rho >> 4, i = rho & 15; return 8 * (i >> 2) + 4 * n + (i & 3); }

struct Unit { int pm, pn, kc; };
struct Gemm { const bf16_t* A; const bf16_t* Bt; int lda, ldb, K; };

struct OrderMN {
    int nM, nN, nwg, G, c;
    __device__ void init(int nM_, int nN_, int G_, int c_) { nM = nM_; nN = nN_; nwg = nM * nN; G = G_; c = c_; }
    __device__ bool next(int i, Unit& u) const {
        const long L = (long)i * G + c; if (L >= nwg) return false;
        int wgid = (int)L; { const int q = nwg / NXCD, r = nwg % NXCD, xcd = wgid % NXCD, off = wgid / NXCD; wgid = (xcd < r ? xcd * (q + 1) : r * (q + 1) + (xcd - r) * q) + off; }
        const int nig = WGM * nN, gid = wgid / nig, fm = gid * WGM, gsz = (nM - fm) < WGM ? (nM - fm) : WGM;
        u.pm = fm + ((wgid % nig) % gsz); u.pn = (wgid % nig) / gsz; u.kc = 0; return true;
    }
    __device__ __forceinline__ int ktiles(const Gemm& g, const Unit&) const { return g.K / BK; }
    __device__ __forceinline__ const char* aptr(const Gemm& g, const Unit& u) const { return (const char*)(g.A + (size_t)u.pm * BM * g.lda); }
    __device__ __forceinline__ const char* bptr(const Gemm& g, const Unit& u) const { return (const char*)(g.Bt + (size_t)u.pn * BM * g.ldb); }
};

template <class Epi, class Sched>
__device__ __forceinline__ void gemm_phase(LAS unsigned char* lds, const Gemm g, const Sched& S, const Epi& E, int wv) {
    const int tid = opaque_tid(wv), wid = __builtin_amdgcn_readfirstlane(tid >> 6), lane = tid & 63, wr = wid >> 2, wc = wid & 3, fr = lane & 15, fq = lane >> 4;
    unsigned voffA[2], voffB[2];
#pragma unroll
    for (int i = 0; i < 2; ++i) { int R, C; stage_rc(tid * 16 + i * 8192, R, C); const int Rb = Epi::PERM ? ((R & ~31) + perm32(R & 31)) : R;
        voffA[i] = (unsigned)(R * g.lda + C) * 2u; voffB[i] = (unsigned)(Rb * g.ldb + C) * 2u; }
    const size_t kstep = (size_t)(BK * 2);
    const size_t hsA = (size_t)HALF * g.lda * 2, hsB = (size_t)HALF * g.ldb * 2;
    const unsigned ldsw = (unsigned)wid * 1024u;
    const int aoff = lds_byte(wr * 64 + fr, fq * 8), boff = lds_byte(wc * 32 + fr, fq * 8);
#define PG8_SA(b, h) (((b) * 2 + (h)) * HTB)
#define PG8_SB(b, h) ((4 + (b) * 2 + (h)) * HTB)
#define PG8_STAGE(bufoff, gbase, voff) do { _Pragma("unroll") for (int _i = 0; _i < 2; ++_i) \
        __builtin_amdgcn_global_load_lds((const unsigned*)((const char*)(gbase) + (voff)[_i]), (LAS unsigned*)(lds + (bufoff) + ldsw + _i * 8192), 16, 0, 0); } while (0)
#define PG8_LDA(dst, b, h) do { _Pragma("unroll") for (int m = 0; m < 4; ++m) _Pragma("unroll") for (int k = 0; k < 2; ++k) dst[m][k] = *(const LAS bf16x8*)(lds + PG8_SA(b, h) + aoff + m * 2048 + k * 1024); } while (0)
#define PG8_LDB(dst, b, h) do { _Pragma("unroll") for (int n = 0; n < 2; ++n) _Pragma("unroll") for (int k = 0; k < 2; ++k) dst[n][k] = *(const LAS bf16x8*)(lds + PG8_SB(b, h) + boff + n * 2048 + k * 1024); } while (0)
#define PG8_MMA(ai, bj, At, Bt) do { __builtin_amdgcn_s_setprio(1); _Pragma("unroll") for (int m = 0; m < 4; ++m) _Pragma("unroll") for (int n = 0; n < 2; ++n) _Pragma("unroll") for (int k = 0; k < 2; ++k) \
        acc[ai][bj][m][n] = __builtin_amdgcn_mfma_f32_16x16x32_bf16(Bt[n][k], At[m][k], acc[ai][bj][m][n], 0, 0, 0); __builtin_amdgcn_s_setprio(0); } while (0)
#define PG8_WAIT_V(n) asm volatile("s_waitcnt vmcnt(" #n ")" ::: "memory")
#define PG8_WAIT_L(n) asm volatile("s_waitcnt lgkmcnt(" #n ")" ::: "memory")
#define PG8_BAR __builtin_amdgcn_s_barrier()
#define PG8_SCHED __builtin_amdgcn_sched_barrier(0)
    Unit cur, nxt; int ui = 0;
    if (!S.next(0, cur)) return;
    int nt = S.ktiles(g, cur); asm volatile("" : "+s"(nt));
    bool half = cur.pm == NPAN_ - 1;
    f32x4 acc[2][2][4][2];
#pragma unroll
    for (int a = 0; a < 2; ++a)
#pragma unroll
        for (int b = 0; b < 2; ++b)
#pragma unroll
            for (int m = 0; m < 4; ++m)
#pragma unroll
                for (int n = 0; n < 2; ++n) acc[a][b][m][n] = (f32x4){0.f, 0.f, 0.f, 0.f};
    bf16x8 At[4][2], B0[2][2], B1[2][2];
    const char* cA = S.aptr(g, cur); const char* cB = S.bptr(g, cur);
    typename Epi::Pre pre = E.pre(cur, wr, wc, fr, fq);
    PG8_STAGE(PG8_SB(0, 0), cB, voffB); PG8_STAGE(PG8_SA(0, 0), cA, voffA); PG8_STAGE(PG8_SB(0, 1), cB + hsB, voffB); PG8_STAGE(PG8_SA(0, 1), cA + hsA, voffA);
    if (wr == 1) PG8_BAR;
    PG8_WAIT_V(4); PG8_BAR;
    PG8_STAGE(PG8_SB(1, 0), cB + kstep, voffB); PG8_STAGE(PG8_SA(1, 0), cA + kstep, voffA); PG8_STAGE(PG8_SB(1, 1), cB + hsB + kstep, voffB);
    PG8_WAIT_V(6); PG8_BAR;
    for (;;) {
        const bool has_next = S.next(ui + 1, nxt);
        const char* nA = has_next ? S.aptr(g, nxt) : cA; const char* nB = has_next ? S.bptr(g, nxt) : cB;
        for (int t = 0; t < nt; t += 2) {
            const bool last = (t == nt - 2);
            const char* a1 = cA + (size_t)(t + 1) * kstep;
            const char* a2 = last ? nA : cA + (size_t)(t + 2) * kstep; const char* b2 = last ? nB : cB + (size_t)(t + 2) * kstep;
            const char* a3 = a2 + kstep; const char* b3 = b2 + kstep;
            PG8_LDB(B0, 0, 0); PG8_SCHED; PG8_LDA(At, 0, 0); PG8_STAGE(PG8_SA(1, 1), a1 + hsA, voffA);
            PG8_WAIT_L(8); PG8_BAR; PG8_WAIT_L(0); PG8_MMA(0, 0, At, B0); PG8_BAR; PG8_SCHED;
            PG8_LDB(B1, 0, 1); PG8_STAGE(PG8_SB(0, 0), b2, voffB);
            PG8_BAR; PG8_WAIT_L(0); PG8_MMA(0, 1, At, B1); PG8_BAR;
            PG8_LDA(At, 0, 1); PG8_STAGE(PG8_SA(0, 0), a2, voffA);
            PG8_BAR; PG8_WAIT_L(0); if (!half) PG8_MMA(1, 0, At, B0); PG8_BAR; PG8_SCHED;
            PG8_STAGE(PG8_SB(0, 1), b2 + hsB, voffB);
            PG8_WAIT_V(6); PG8_BAR; if (!half) PG8_MMA(1, 1, At, B1); PG8_BAR;
            PG8_LDB(B0, 1, 0); PG8_SCHED; PG8_LDA(At, 1, 0); PG8_STAGE(PG8_SA(0, 1), a2 + hsA, voffA);
            PG8_WAIT_L(8); PG8_BAR; PG8_WAIT_L(0); PG8_MMA(0, 0, At, B0); PG8_BAR; PG8_SCHED;
            PG8_LDB(B1, 1, 1); PG8_STAGE(PG8_SB(1, 0), b3, voffB);
            PG8_BAR; PG8_WAIT_L(0); PG8_MMA(0, 1, At, B1); PG8_BAR;
            PG8_LDA(At, 1, 1); PG8_STAGE(PG8_SA(1, 0), a3, voffA);
            PG8_BAR; PG8_WAIT_L(0); if (!half) PG8_MMA(1, 0, At, B0); PG8_BAR; PG8_SCHED;
            PG8_STAGE(PG8_SB(1, 1), b3 + hsB, voffB);
            PG8_WAIT_V(6); PG8_BAR; if (!half) PG8_MMA(1, 1, At, B1); PG8_BAR;
        }
        E(acc, cur, wr, wc, fr, fq, pre);
        if (!has_next) break;
        pre = E.pre(nxt, wr, wc, fr, fq);
#pragma unroll
        for (int a = 0; a < 2; ++a)
#pragma unroll
            for (int b = 0; b < 2; ++b)
#pragma unroll
                for (int m = 0; m < 4; ++m)
#pragma unroll
                    for (int n = 0; n < 2; ++n) acc[a][b][m][n] = (f32x4){0.f, 0.f, 0.f, 0.f};
        cur = nxt; cA = nA; cB = nB; ++ui; nt = S.ktiles(g, cur); half = cur.pm == NPAN_ - 1;
    }
    PG8_WAIT_V(0);
    if (wr == 0) PG8_BAR;
    PG8_BAR;
#undef PG8_SA
#undef PG8_SB
#undef PG8_STAGE
#undef PG8_LDA
#undef PG8_LDB
#undef PG8_MMA
#undef PG8_WAIT_V
#undef PG8_WAIT_L
#undef PG8_BAR
#undef PG8_SCHED
}
}

typedef f32x4 AccT[2][2][4][2];
__device__ __forceinline__ float shfl_xor_l(float v, int o, int lane) { return __builtin_bit_cast(float, __builtin_amdgcn_ds_bpermute((lane ^ o) << 2, __builtin_bit_cast(int, v))); }
__device__ __forceinline__ float rsum4(const f32x4 v) { return (v[0] * v[0] + v[1] * v[1]) + (v[2] * v[2] + v[3] * v[3]); }
__device__ __forceinline__ float red_fq(float s, int lane) { s += shfl_xor_l(s, 16, lane); s += shfl_xor_l(s, 32, lane); return s; }
#define PH_IDS const int tid_ = opaque_tid(c.wv), lane_ = tid_ & 63, wave_ = __builtin_amdgcn_readfirstlane(tid_ >> 6); (void)lane_; (void)wave_
#define ROW_OK(u, ai) (!((u).pm == NPAN - 1 && (ai) == 1))

struct EpiSgu {
    static constexpr bool PERM = true;
    const float* ss; bf16_t* U; bf16_t* V; float* vss; float* slab;
    struct Pre { float rs[2][4]; };
    __device__ __forceinline__ Pre pre(const pg8::Unit& u, int wr, int wc, int fr, int fq) const { Pre p; const int row0 = u.pm * 256 + wr * 64 + fr;
#pragma unroll
        for (int ai = 0; ai < 2; ++ai)
#pragma unroll
            for (int m = 0; m < 4; ++m) p.rs[ai][m] = ROW_OK(u, ai) ? ss[row0 + ai * 128 + m * 16] : 1.f;
        return p; }
    __device__ __forceinline__ void operator()(const AccT& acc, const pg8::Unit& u, int wr, int wc, int fr, int fq, const Pre& pre) const {
        const int row0 = u.pm * 256 + wr * 64 + fr; const int colt = u.pn * 256; const bool isV = colt >= DSGU;
        if (u.pm == NPAN - 1) {
#pragma unroll
            for (int m = 0; m < 4; ++m) { float* sp = slab + ((size_t)u.kc * MS + (wr * 64 + m * 16 + fr)) * 4096 + colt + wc * 32 + 8 * fq;
#pragma unroll
                for (int bj = 0; bj < 2; ++bj) { *(f32x4*)(sp + bj * 128) = acc[0][bj][m][0]; *(f32x4*)(sp + bj * 128 + 4) = acc[0][bj][m][1]; } }
            return;
        }
        bf16_t* base = isV ? V : U; const int cb = (isV ? colt - DSGU : colt) + wc * 32 + 8 * fq;
#pragma unroll
        for (int ai = 0; ai < 2; ++ai) { if (!ROW_OK(u, ai)) continue;
#pragma unroll
            for (int m = 0; m < 4; ++m) { const int row = row0 + ai * 128 + m * 16; const float rstd = rsqrtf(pre.rs[ai][m] * (1.0f / D) + EPS); float sq = 0.f;
#pragma unroll
                for (int bj = 0; bj < 2; ++bj) { f32x4 v0 = acc[ai][bj][m][0] * rstd, v1 = acc[ai][bj][m][1] * rstd;
#pragma unroll
                    for (int j = 0; j < 4; ++j) { v0[j] = gelu_tanh(v0[j]); v1[j] = gelu_tanh(v1[j]); }
                    sq += rsum4(v0) + rsum4(v1);
                    u32x4 w; w.x = cvt_pk_bf16(v0[0], v0[1]); w.y = cvt_pk_bf16(v0[2], v0[3]); w.z = cvt_pk_bf16(v1[0], v1[1]); w.w = cvt_pk_bf16(v1[2], v1[3]);
                    *(u32x4*)(base + (size_t)row * DSGU + cb + bj * 128) = w; }
                if (isV) { sq = red_fq(sq, fr + 16 * fq); if (fq == 0) vss[(size_t)row * 32 + (u.pn - 8) * 4 + wc] = sq; } } }
    }
};
struct EpiRes {
    static constexpr bool PERM = true;
    bf16_t* Hb; float* ssout; float* slab; bf16_t* Hd;
    struct Pre {};
    __device__ __forceinline__ Pre pre(const pg8::Unit&, int, int, int, int) const { return Pre{}; }
    __device__ __forceinline__ void operator()(const AccT& acc, const pg8::Unit& u, int wr, int wc, int fr, int fq, const Pre& pre) const {
        const int row0 = u.pm * 256 + wr * 64 + fr; const int col0 = u.pn * 256 + wc * 32 + 8 * fq;
        if (u.pm == NPAN - 1) {
#pragma unroll
            for (int m = 0; m < 4; ++m) { float* sp = slab + ((size_t)u.kc * MS + (wr * 64 + m * 16 + fr)) * D + col0;
#pragma unroll
                for (int bj = 0; bj < 2; ++bj) { *(f32x4*)(sp + bj * 128) = acc[0][bj][m][0]; *(f32x4*)(sp + bj * 128 + 4) = acc[0][bj][m][1]; } }
            return;
        }
#pragma unroll
        for (int ai = 0; ai < 2; ++ai) {
            u32x4 ball[4][2];
#pragma unroll
            for (int m = 0; m < 4; ++m)
#pragma unroll
                for (int bj = 0; bj < 2; ++bj) ball[m][bj] = *(const u32x4*)(Hb + (size_t)(row0 + ai * 128 + m * 16) * D + col0 + bj * 128);
#pragma unroll
            for (int m = 0; m < 4; ++m) { const int row = row0 + ai * 128 + m * 16; bf16_t* hp = Hb + (size_t)row * D + col0; float sq = 0.f;
                u32x4 b[2] = {ball[m][0], ball[m][1]};
#pragma unroll
                for (int bj = 0; bj < 2; ++bj) { const f32x4 a0 = acc[ai][bj][m][0], a1 = acc[ai][bj][m][1]; float o[8];
                    o[0] = bf_lo(b[bj].x) + a0[0]; o[1] = bf_hi(b[bj].x) + a0[1]; o[2] = bf_lo(b[bj].y) + a0[2]; o[3] = bf_hi(b[bj].y) + a0[3];
                    o[4] = bf_lo(b[bj].z) + a1[0]; o[5] = bf_hi(b[bj].z) + a1[1]; o[6] = bf_lo(b[bj].w) + a1[2]; o[7] = bf_hi(b[bj].w) + a1[3];
#pragma unroll
                    for (int i = 0; i < 8; ++i) sq += o[i] * o[i];
                    u32x4 w; w.x = cvt_pk_bf16(o[0], o[1]); w.y = cvt_pk_bf16(o[2], o[3]); w.z = cvt_pk_bf16(o[4], o[5]); w.w = cvt_pk_bf16(o[6], o[7]);
                    *(u32x4*)(Hd + (size_t)row * D + col0 + bj * 128) = w; }
                sq = red_fq(sq, fr + 16 * fq); if (fq == 0) ssout[(size_t)row * 32 + u.pn * 4 + wc] = sq; } }
    }
};
struct EpiFfn {
    static constexpr bool PERM = true;
    const float* ss; bf16_t* F;
    struct Pre { float rs[2][4]; };
    __device__ __forceinline__ Pre pre(const pg8::Unit& u, int wr, int wc, int fr, int fq) const { Pre p; const int row0 = u.pm * 256 + wr * 64 + fr;
#pragma unroll
        for (int ai = 0; ai < 2; ++ai)
#pragma unroll
            for (int m = 0; m < 4; ++m) p.rs[ai][m] = ROW_OK(u, ai) ? ss[row0 + ai * 128 + m * 16] : 1.f;
        return p; }
    __device__ __forceinline__ void operator()(const AccT& acc, const pg8::Unit& u, int wr, int wc, int fr, int fq, const Pre& pre) const {
        const int row0 = u.pm * 256 + wr * 64 + fr; const int col = u.pn * 128 + wc * 32 + 8 * fq;
#pragma unroll
        for (int ai = 0; ai < 2; ++ai) { if (!ROW_OK(u, ai)) continue;
#pragma unroll
            for (int m = 0; m < 4; ++m) { const int row = row0 + ai * 128 + m * 16; const float rstd = rsqrtf(pre.rs[ai][m] * (1.0f / D) + EPS);
                float f[8];
#pragma unroll
                for (int n = 0; n < 2; ++n)
#pragma unroll
                    for (int j = 0; j < 4; ++j) f[n * 4 + j] = silu_f(acc[ai][0][m][n][j] * rstd) * (acc[ai][1][m][n][j] * rstd);
                u32x4 w; w.x = cvt_pk_bf16(f[0], f[1]); w.y = cvt_pk_bf16(f[2], f[3]); w.z = cvt_pk_bf16(f[4], f[5]); w.w = cvt_pk_bf16(f[6], f[7]);
                *(u32x4*)(F + (size_t)row * DFF + col) = w; } }
    }
};
struct EpiKvq {
    static constexpr bool PERM = true;
    const float* ss; float* KVR; float* ssp; bf16_t* CQ; int c_end, kv_end, cq_end;
    struct Pre { float rs[2][4]; };
    __device__ __forceinline__ Pre pre(const pg8::Unit& u, int wr, int wc, int fr, int fq) const { Pre p; const int row0 = u.pm * 256 + wr * 64 + fr;
#pragma unroll
        for (int ai = 0; ai < 2; ++ai)
#pragma unroll
            for (int m = 0; m < 4; ++m) p.rs[ai][m] = ROW_OK(u, ai) ? ss[row0 + ai * 128 + m * 16] : 1.f;
        return p; }
    __device__ __forceinline__ void operator()(const AccT& acc, const pg8::Unit& u, int wr, int wc, int fr, int fq, const Pre& pre) const {
        const int row0 = u.pm * 256 + wr * 64 + fr; const int colt = u.pn * 256;
        const bool hasC = colt < c_end, hasQ = (colt + 256 > kv_end) && (colt < cq_end);
#pragma unroll
        for (int ai = 0; ai < 2; ++ai) { if (!ROW_OK(u, ai)) continue;
#pragma unroll
            for (int m = 0; m < 4; ++m) { const int row = row0 + ai * 128 + m * 16; const float rstd = rsqrtf(pre.rs[ai][m] * (1.0f / D) + EPS); float sqc = 0.f, sqq = 0.f;
#pragma unroll
                for (int bj = 0; bj < 2; ++bj) { const int col = colt + bj * 128 + wc * 32 + 8 * fq; const f32x4 v0 = acc[ai][bj][m][0] * rstd, v1 = acc[ai][bj][m][1] * rstd;
                    if (col < kv_end) { *(f32x4*)(KVR + (size_t)row * QKD + col) = v0; *(f32x4*)(KVR + (size_t)row * QKD + col + 4) = v1; if (col < c_end) sqc += rsum4(v0) + rsum4(v1); }
                    else if (col < cq_end) { sqq += rsum4(v0) + rsum4(v1);
                        u32x4 w; w.x = cvt_pk_bf16(v0[0], v0[1]); w.y = cvt_pk_bf16(v0[2], v0[3]); w.z = cvt_pk_bf16(v1[0], v1[1]); w.w = cvt_pk_bf16(v1[2], v1[3]);
                        *(u32x4*)(CQ + (size_t)row * QLR + (col - kv_end)) = w; } }
                if (hasC) { sqc = red_fq(sqc, fr + 16 * fq); if (fq == 0) ssp[(size_t)row * 32 + wc] = sqc; }
                if (hasQ) { sqq = red_fq(sqq, fr + 16 * fq); if (fq == 0) ssp[(size_t)row * 32 + 8 + 4 * (u.pn - (kv_end ? 1 : 0)) + wc] = sqq; } } }
    }
};
struct EpiQ {
    static constexpr bool PERM = true;
    const float* ssp; bf16_t* QF; const f32x2* rope; bf16_t* QH;
    struct Pre {};
    __device__ __forceinline__ Pre pre(const pg8::Unit&, int, int, int, int) const { return Pre{}; }
    __device__ __forceinline__ void operator()(const AccT& acc, const pg8::Unit& u, int wr, int wc, int fr, int fq, const Pre& pre) const {
        const int row0 = u.pm * 256 + wr * 64 + fr; const int colt = u.pn * 256; const bool sample = u.pm == NPAN - 1;
        float rs[2][4];
#pragma unroll
        for (int ai = 0; ai < 2; ++ai)
#pragma unroll
            for (int m = 0; m < 4; ++m) { rs[ai][m] = 1.f; if (ROW_OK(u, ai)) { const float* pp = ssp + (size_t)(row0 + ai * 128 + m * 16) * 32 + 8; const f32x4 pa = *(const f32x4*)pp, pb = *(const f32x4*)(pp + 4);
                rs[ai][m] = ((pa[0] + pa[1]) + (pa[2] + pa[3])) + ((pb[0] + pb[1]) + (pb[2] + pb[3])); } }
#pragma unroll
        for (int ai = 0; ai < 2; ++ai) { if (!ROW_OK(u, ai)) continue;
#pragma unroll
            for (int m = 0; m < 4; ++m) { const int row = row0 + ai * 128 + m * 16;
                const float rstd = rsqrtf(rs[ai][m] * (1.0f / QLR) + EPS) * QSCALE;
                const int pidx = sample ? SEQ : (row & (SEQ - 1));
#pragma unroll
                for (int bj = 0; bj < 2; ++bj) { const int col = colt + bj * 128 + wc * 32 + 8 * fq;
                    if (!sample) {
                        const int hh = col / 192, c2 = col - hh * 192; float q[8];
#pragma unroll
                        for (int jj = 0; jj < 4; ++jj) { q[jj] = acc[ai][bj][m][0][jj] * rstd; q[4 + jj] = acc[ai][bj][m][1][jj] * rstd; }
                        if (c2 >= 128) { const int i0 = (c2 - 128) >> 1;
#pragma unroll
                            for (int pp = 0; pp < 4; ++pp) { const f32x2 cs = rope[pidx * 32 + i0 + pp]; const float x1 = q[2 * pp], x2 = q[2 * pp + 1]; q[2 * pp] = x1 * cs.x - x2 * cs.y; q[2 * pp + 1] = x2 * cs.x + x1 * cs.y; } }
                        u32x4 w; w.x = cvt_pk_bf16(q[0], q[1]); w.y = cvt_pk_bf16(q[2], q[3]); w.z = cvt_pk_bf16(q[4], q[5]); w.w = cvt_pk_bf16(q[6], q[7]);
                        *(u32x4*)(QH + (size_t)row * 3072 + col) = w; continue; }
                    const int head = col / QKD, cc = col - head * QKD;
                    float v[8];
#pragma unroll
                    for (int j = 0; j < 4; ++j) { v[j] = acc[ai][bj][m][0][j] * rstd; v[4 + j] = acc[ai][bj][m][1][j] * rstd; }
                    bf16_t* dst = QF + (size_t)row * NQ + col;
                    if (cc < KVC) { u32x4 w; w.x = cvt_pk_bf16(v[0], v[1]); w.y = cvt_pk_bf16(v[2], v[3]); w.z = cvt_pk_bf16(v[4], v[5]); w.w = cvt_pk_bf16(v[6], v[7]); *(u32x4*)dst = w; }
                    else { const int i0 = (cc - KVC) >> 1; float o1[4], o2[4];
#pragma unroll
                        for (int p = 0; p < 4; ++p) { const f32x2 cs = rope[pidx * 32 + i0 + p]; o1[p] = v[2 * p] * cs.x - v[2 * p + 1] * cs.y; o2[p] = v[2 * p + 1] * cs.x + v[2 * p] * cs.y; }
                        if (!sample) { u32x4 w; w.x = cvt_pk_bf16(o1[0], o2[0]); w.y = cvt_pk_bf16(o1[1], o2[1]); w.z = cvt_pk_bf16(o1[2], o2[2]); w.w = cvt_pk_bf16(o1[3], o2[3]); *(u32x4*)dst = w; }
                        else { bf16_t* hb = QF + (size_t)row * NQ + head * QKD + KVC;
                            u32x2 a, b; a.x = cvt_pk_bf16(o1[0], o1[1]); a.y = cvt_pk_bf16(o1[2], o1[3]); b.x = cvt_pk_bf16(o2[0], o2[1]); b.y = cvt_pk_bf16(o2[2], o2[3]);
                            *(u32x2*)(hb + i0) = a; *(u32x2*)(hb + 32 + i0) = b; } } }
                asm volatile("" ::: "memory"); } }
    }
};
struct EpiPlain {
    static constexpr bool PERM = true;
    bf16_t* O; int ldc;
    struct Pre {};
    __device__ __forceinline__ Pre pre(const pg8::Unit&, int, int, int, int) const { return Pre{}; }
    __device__ __forceinline__ void operator()(const AccT& acc, const pg8::Unit& u, int wr, int wc, int fr, int fq, const Pre& pre) const {
        const int row0 = u.pm * 256 + wr * 64 + fr; const int col0 = u.pn * 256 + wc * 32 + 8 * fq;
#pragma unroll
        for (int ai = 0; ai < 2; ++ai) { if (!ROW_OK(u, ai)) continue;
#pragma unroll
            for (int m = 0; m < 4; ++m) { const int row = row0 + ai * 128 + m * 16;
#pragma unroll
                for (int bj = 0; bj < 2; ++bj) { const f32x4 v0 = acc[ai][bj][m][0], v1 = acc[ai][bj][m][1];
                    u32x4 w; w.x = cvt_pk_bf16(v0[0], v0[1]); w.y = cvt_pk_bf16(v0[2], v0[3]); w.z = cvt_pk_bf16(v1[0], v1[1]); w.w = cvt_pk_bf16(v1[2], v1[3]);
                    *(u32x4*)(O + (size_t)row * ldc + col0 + bj * 128) = w; } } }
    }
};
struct EpiKvup {
    static constexpr bool PERM = true;
    bf16_t* KN; bf16_t* VH;
    struct Pre {};
    __device__ __forceinline__ Pre pre(const pg8::Unit&, int, int, int, int) const { return Pre{}; }
    __device__ __forceinline__ void operator()(const AccT& acc, const pg8::Unit& u, int wr, int wc, int fr, int fq, const Pre&) const {
        const int row0 = u.pm * 256 + wr * 64 + fr;
#pragma unroll
        for (int ai = 0; ai < 2; ++ai)
#pragma unroll
            for (int m = 0; m < 4; ++m) { const int row = row0 + ai * 128 + m * 16; const size_t o = ((size_t)((row >> 11) * NH + u.pn) * SEQ + (row & (SEQ - 1))) * 128 + wc * 32 + 8 * fq;
#pragma unroll
                for (int bj = 0; bj < 2; ++bj) { const f32x4 v0 = acc[ai][bj][m][0], v1 = acc[ai][bj][m][1];
                    u32x4 w; w.x = cvt_pk_bf16(v0[0], v0[1]); w.y = cvt_pk_bf16(v0[2], v0[3]); w.z = cvt_pk_bf16(v1[0], v1[1]); w.w = cvt_pk_bf16(v1[2], v1[3]);
                    *(u32x4*)((bj ? VH : KN) + o) = w; } }
    }
};
struct OrderAbs {
    int G, c;
    __device__ bool next(int i, pg8::Unit& u) const { const int L = i * G + c; if (L >= 64) return false; u.pm = L >> 1; u.pn = L & 1; u.kc = 0; return true; }
    __device__ __forceinline__ int ktiles(const pg8::Gemm& g, const pg8::Unit&) const { return g.K / pg8::BK; }
    __device__ __forceinline__ const char* aptr(const pg8::Gemm& g, const pg8::Unit& u) const { return (const char*)(g.A + (size_t)(u.pm & 15) * 65536); }
    __device__ __forceinline__ const char* bptr(const pg8::Gemm& g, const pg8::Unit& u) const { return (const char*)(g.Bt + ((size_t)u.pm * 512 + u.pn * 256) * 256); }
};
struct EpiAbs {
    static constexpr bool PERM = true;
    bf16_t* WQ;
    struct Pre {};
    __device__ __forceinline__ Pre pre(const pg8::Unit&, int, int, int, int) const { return Pre{}; }
    __device__ __forceinline__ void operator()(const AccT& acc, const pg8::Unit& u, int wr, int wc, int fr, int fq, const Pre& pre) const {
        const int j = u.pm >> 4, h = u.pm & 15; bf16_t* base = WQ + ((size_t)j * NQ + h * QKD) * QLR;
#pragma unroll
        for (int ai = 0; ai < 2; ++ai)
#pragma unroll
            for (int m = 0; m < 4; ++m) { const int c = wr * 64 + ai * 128 + m * 16 + fr;
#pragma unroll
                for (int bj = 0; bj < 2; ++bj) { const int r = u.pn * 256 + bj * 128 + wc * 32 + 8 * fq; const f32x4 v0 = acc[ai][bj][m][0], v1 = acc[ai][bj][m][1];
                    u32x4 w; w.x = cvt_pk_bf16(v0[0], v0[1]); w.y = cvt_pk_bf16(v0[2], v0[3]); w.z = cvt_pk_bf16(v1[0], v1[1]); w.w = cvt_pk_bf16(v1[2], v1[3]);
                    if (r < QLR) *(u32x4*)(base + (size_t)c * QLR + r) = w; }
                asm volatile("" ::: "memory"); }
    }
};
struct OrderRes {
    pg8::OrderMN base; int nN, nkc, nreg;
    __device__ void init(int nN_, int nkc_, int G_, int c_) { base.init(64, nN_, G_, c_); nN = nN_; nkc = nkc_; nreg = 64 * nN_; }
    __device__ bool next(int i, pg8::Unit& u) const { const int L = i * base.G + base.c; if (L < nreg) return base.next(i, u);
        const int idx = L - nreg; if (idx >= nkc * nN) return false; u.pm = NPAN - 1; u.pn = idx % nN; u.kc = idx / nN; return true; }
    __device__ __forceinline__ const char* aptr(const pg8::Gemm& g, const pg8::Unit& u) const { return (const char*)(g.A + (size_t)u.pm * 256 * g.lda + (size_t)u.kc * 256); }
    __device__ __forceinline__ const char* bptr(const pg8::Gemm& g, const pg8::Unit& u) const { return (const char*)(g.Bt + (size_t)u.pn * 256 * g.ldb + (size_t)u.kc * 256); }
    __device__ __forceinline__ int ktiles(const pg8::Gemm& g, const pg8::Unit& u) const { return u.pm == NPAN - 1 ? 4 : g.K / pg8::BK; }
};
struct OrderQ2 {
    pg8::OrderMN base; const bf16_t* babs;
    __device__ void init(const bf16_t* babs_, int G_, int c_) { base.init(64, 12, G_, c_); babs = babs_; }
    __device__ bool next(int i, pg8::Unit& u) const { const int L = i * base.G + base.c; if (L < 768) return base.next(i, u);
        const int idx = L - 768; if (idx >= 20) return false; u.pm = NPAN - 1; u.pn = idx; u.kc = 0; return true; }
    __device__ __forceinline__ const char* aptr(const pg8::Gemm& g, const pg8::Unit& u) const { return (const char*)(g.A + (size_t)u.pm * 256 * g.lda); }
    __device__ __forceinline__ const char* bptr(const pg8::Gemm& g, const pg8::Unit& u) const { return (const char*)((u.pm == NPAN - 1 ? babs : g.Bt) + (size_t)u.pn * 256 * g.ldb); }
    __device__ __forceinline__ int ktiles(const pg8::Gemm& g, const pg8::Unit&) const { return g.K / pg8::BK; }
};
struct OrderUvS {
    int G, c;
    __device__ bool next(int i, pg8::Unit& u) const { const int L = i * G + c; if (L >= 8) return false; u.pm = NPAN - 1; u.pn = L; u.kc = 0; return true; }
    __device__ __forceinline__ const char* aptr(const pg8::Gemm& g, const pg8::Unit& u) const { return (const char*)(g.A + (size_t)u.pm * 256 * g.lda + (size_t)u.pn * 512); }
    __device__ __forceinline__ const char* bptr(const pg8::Gemm& g, const pg8::Unit& u) const { return (const char*)(g.Bt + (size_t)u.pn * 256 * g.ldb); }
    __device__ __forceinline__ int ktiles(const pg8::Gemm& g, const pg8::Unit&) const { return g.K / pg8::BK; }
};
struct OrderUv : pg8::OrderMN {
    __device__ __forceinline__ const char* aptr(const pg8::Gemm& g, const pg8::Unit& u) const { return (const char*)(g.A + (size_t)u.pm * 256 * g.lda + (size_t)u.pn * 512); }
};

struct Ctx {
    float* out; unsigned char* ws; LAS unsigned char* lds; int G, bid, wv;
    __device__ __forceinline__ const float* in(int i) const { int z = 0; asm volatile("" : "+s"(z));
        const void* const __attribute__((address_space(4)))* ka = (const void* const __attribute__((address_space(4)))*)__builtin_amdgcn_kernarg_segment_ptr(); return (const float*)ka[i + z]; }
    template <class T> __device__ __forceinline__ T* wsp(size_t off) const { return (T*)(ws + off); }
    __device__ __forceinline__ float* ss(int i) const { return (float*)(ws + WS_SS) + (size_t)i * MPAD; }
};

__device__ __forceinline__ int rope_perm(int e) { return (e & 1) ? 32 + (e >> 1) : (e >> 1); }

__device__ __forceinline__ void conv_sub(const Ctx& c, const float* src, int ld, const float* gain, int K, bf16_t* dst, int lddst, int N, int mode, int first, int stride) {
    PH_IDS;
    constexpr int LDT = 132;
    LAS bf16_t* T = (LAS bf16_t*)c.lds;
    const int tk = K / 128, tn = N / 128, ntile = tk * tn;
    const int nl0 = tid_ & 127, kq = tid_ >> 7;
    for (int tile = first; tile < ntile; tile += stride) {
        const int k0 = (tile % tk) * 128, n0 = (tile / tk) * 128;
        int col0 = n0;
        if (mode == 1) { const int pn = n0 >> 8, r = n0 & 255; col0 = r < 128 ? pn * 128 + r : DFF + pn * 128 + (r - 128); }
        int nl = nl0;
        if (mode == 3) { const int cN = n0 + nl0, hh = cN / 192, e = cN - hh * 192; if (e >= 128) { const int rho = e - 128; nl = hh * 192 + 128 + (rho < 32 ? 2 * rho : 2 * (rho - 32) + 1) - n0; } }
        const float* sp = src + (size_t)(k0 + 32 * kq) * ld + col0 + nl0;
        float v[32];
#pragma unroll
        for (int i = 0; i < 32; ++i) v[i] = sp[(size_t)i * ld];
        if (gain) {
#pragma unroll
            for (int i = 0; i < 32; i += 4) { const f32x4 g4 = *(const f32x4*)(gain + k0 + 32 * kq + i); v[i] *= g4[0]; v[i + 1] *= g4[1]; v[i + 2] *= g4[2]; v[i + 3] *= g4[3]; } }
#pragma unroll
        for (int i = 0; i < 32; i += 4) { u32x2 w; w.x = cvt_pk_bf16(v[i], v[i + 1]); w.y = cvt_pk_bf16(v[i + 2], v[i + 3]); *(LAS u32x2*)(T + nl * LDT + 32 * kq + i) = w; }
        __syncthreads();
        { const int n = tid_ >> 2, part = tid_ & 3; int koff = k0; if (mode == 2) koff += ((n0 >> 7) & 1) * 256;
            bf16_t* drow = dst + (size_t)((mode == 4 || mode == 5) ? (n0 >> 7) * 256 + (mode == 5 ? 128 : 0) + n : n0 + n) * lddst;
#pragma unroll
            for (int q = 0; q < 4; ++q) { const LAS u32x2* tp = (const LAS u32x2*)(T + n * LDT + part * 32 + q * 8); const u32x2 lo = tp[0], hi = tp[1];
                *(u32x4*)(drow + koff + part * 32 + q * 8) = (u32x4){lo.x, lo.y, hi.x, hi.y};
                if (mode == 2) *(u32x4*)(drow + (koff ^ 256) + part * 32 + q * 8) = (u32x4){0u, 0u, 0u, 0u}; } }
        __syncthreads();
    }
}
__device__ __forceinline__ void conv_t(const Ctx& c, const float* src, int ld, const float* gain, int K, bf16_t* dst, int lddst, int N, int mode, int& rr) {
    conv_sub(c, src, ld, gain, K, dst, lddst, N, mode, (c.bid + rr) % c.G, c.G); rr += (K / 128) * (N / 128);
}
__device__ __forceinline__ void conv_sgu_w(const Ctx& c, int l, int first, int stride) {
    conv_sub(c, c.in(6) + (size_t)l * D * 4096, 4096, c.in(5) + l * D, D, c.wsp<bf16_t>(WS_W1) + (size_t)l * 4096 * D, D, 4096, 0, first, stride);
    conv_sub(c, c.in(10) + (size_t)l * DSGU * D, D, nullptr, DSGU, c.wsp<bf16_t>(WS_W3) + (size_t)l * D * DSGU, DSGU, D, 0, first, stride);
}
__device__ __forceinline__ void conv_ffn_w(const Ctx& c, int l, int first, int stride) {
    conv_sub(c, c.in(12) + (size_t)l * D * 2 * DFF, 2 * DFF, c.in(11) + l * D, D, c.wsp<bf16_t>(WS_W4) + (size_t)l * 2 * DFF * D, D, 2 * DFF, 1, first, stride);
    conv_sub(c, c.in(13) + (size_t)l * DFF * D, D, nullptr, DFF, c.wsp<bf16_t>(WS_W5) + (size_t)l * D * DFF, DFF, D, 0, first, stride);
}

__device__ __forceinline__ void phase_prologue(const Ctx& c) {
    PH_IDS;
    const int gtid = c.bid * 512 + tid_, gsz = c.G * 512;
    { f32x2* tab = c.wsp<f32x2>(WS_ROPE);
      for (int e = gtid; e < 2049 * 32; e += gsz) { const int pi = e >> 5, i = e & 31; const double pos = pi < SEQ ? (double)pi : 8192.0;
          double inv = 1.0; for (int k = 0; k < i; ++k) inv *= 0.7498942093324559;
          double x = pos * inv; x -= 6.283185307179586 * __builtin_rint(x * 0.15915494309189535);
          const double x2 = x * x; double sn = 0.0, cs = 0.0;
          { double t = x, s = t; for (int k = 1; k <= 12; ++k) { t *= -x2 / (double)((2 * k) * (2 * k + 1)); s += t; } sn = s; }
          { double t = 1.0, s = t; for (int k = 1; k <= 12; ++k) { t *= -x2 / (double)((2 * k - 1) * (2 * k)); s += t; } cs = s; }
          tab[e] = (f32x2){(float)cs, (float)sn}; } }
    { bf16_t* Hb = c.wsp<bf16_t>(WS_HB); float* ss0 = c.ss(0);
      for (int row = c.bid * 8 + wave_; row < MT; row += c.G * 8) { const float* src = row < MP ? c.in(0) + (size_t)row * D : c.in(1) + (size_t)(row - MP) * D; float sq = 0.f;
#pragma unroll
          for (int i = 0; i < 4; ++i) { const int col = i * 256 + lane_ * 4; const f32x4 v = *(const f32x4*)(src + col); sq += rsum4(v);
              u32x2 w; w.x = cvt_pk_bf16(v[0], v[1]); w.y = cvt_pk_bf16(v[2], v[3]); *(u32x2*)(Hb + (size_t)row * D + col) = w; }
#pragma unroll
          for (int o = 32; o >= 1; o >>= 1) sq += shfl_xor_l(sq, o, lane_);
          if (lane_ == 0) ss0[row] = sq; } }
    conv_sgu_w(c, 0, c.bid, c.G); conv_ffn_w(c, 0, (c.bid + 128) % c.G, c.G);
}
#define CONV_F(src, ld, gain, K, dst, lddst, N, mode) do { conv_sub(c, src, ld, gain, K, dst, lddst, N, mode, (p + rr) % np, np); rr += ((K) / 128) * ((N) / 128); } while (0)
__device__ __forceinline__ void fill_wo(const Ctx& c, int p, int np) { int rr = 0;
    for (int j = 0; j < 2; ++j) CONV_F(c.in(22) + (size_t)j * 2048 * D, D, nullptr, 2048, c.wsp<bf16_t>(WS_WO) + (size_t)j * D * 2048, 2048, D, 0);
}
__device__ __forceinline__ void fill_q(const Ctx& c, int p, int np) { int rr = 0;
    for (int j = 0; j < 2; ++j) CONV_F(c.in(21) + (size_t)j * QLR * 3072, 3072, c.in(20) + j * QLR, QLR, c.wsp<bf16_t>(WS_WQS) + (size_t)j * 3072 * QLR, QLR, 3072, 3);
    CONV_F(c.in(17), NH * 128, nullptr, KVC, c.wsp<bf16_t>(WS_WKV2), KVC, NH * 128, 4);
    CONV_F(c.in(18), NH * 128, nullptr, KVC, c.wsp<bf16_t>(WS_WKV2), KVC, NH * 128, 5);
    CONV_F(c.in(18), NH * 128, nullptr, KVC, c.wsp<bf16_t>(WS_WUV), 512, NH * 128, 2);
}
__device__ __forceinline__ void fill_misc(const Ctx& c, int p, int np) { int rr = 0;
    PH_IDS;
    const int gtid = p * 512 + tid_, gsz = np * 512;
    CONV_F(c.in(15), QKD, c.in(14), D, c.wsp<bf16_t>(WS_WKVQ), D, KVC, 0);
    CONV_F(c.in(19), QLR, c.in(5) + 2 * D, D, c.wsp<bf16_t>(WS_WKVQ) + (size_t)QKD * D, D, QLR, 0);
    CONV_F(c.in(19) + (size_t)D * QLR, QLR, c.in(5) + 3 * D, D, c.wsp<bf16_t>(WS_WDQ1), D, QLR, 0);
    { bf16_t* W = c.wsp<bf16_t>(WS_WKVQ);
      for (int e = gtid; e < 64 * D; e += gsz) { const int n = e >> 10, k = e & 1023; W[(size_t)(KVC + n) * D + k] = (bf16_t)(cvt_pk_bf16(c.in(14)[k] * c.in(15)[(size_t)k * QKD + KVC + rope_perm(n)], 0.f) & 0xffffu); }
      for (int e = gtid; e < 64 * D; e += gsz) W[(size_t)704 * D + e] = 0;
      bf16_t* W1 = c.wsp<bf16_t>(WS_WDQ1); for (int e = gtid; e < 128 * D; e += gsz) W1[(size_t)QLR * D + e] = 0; }
    { bf16_t* WQ = c.wsp<bf16_t>(WS_WQ);
      for (int e = gtid; e < 2 * NH * 64 * QLR; e += gsz) { const int r = e % QLR, t = e / QLR, ep = t & 63, h = (t >> 6) & 15, j = t >> 10;
          const float v = c.in(20)[j * QLR + r] * c.in(21)[((size_t)j * QLR + r) * 3072 + h * 192 + 128 + rope_perm(ep)];
          WQ[((size_t)j * NQ + h * QKD + KVC + ep) * QLR + r] = (bf16_t)(cvt_pk_bf16(v, 0.f) & 0xffffu); } }
    { bf16_t* UK = c.wsp<bf16_t>(WS_UKP);
      for (int e = gtid; e < NH * 256 * 256; e += gsz) { const int d = e & 255, cc = (e >> 8) & 255, h = e >> 16;
          UK[e] = d < 128 ? (bf16_t)(cvt_pk_bf16(c.in(17)[((size_t)cc * NH + h) * 128 + d], 0.f) & 0xffffu) : (bf16_t)0; } }
    { bf16_t* UQ = c.wsp<bf16_t>(WS_UQP);
      for (int e = gtid; e < 2 * NH * 512 * 256; e += gsz) { const int d = e & 255, r = (e >> 8) & 511, h = (e >> 17) & 15, j = e >> 21;
          UQ[e] = (d < 128 && r < QLR) ? (bf16_t)(cvt_pk_bf16(c.in(20)[j * QLR + r] * c.in(21)[((size_t)j * QLR + r) * 3072 + h * 192 + d], 0.f) & 0xffffu) : (bf16_t)0; } }
}
#undef CONV_F

__device__ __forceinline__ void phase_mix(const Ctx& c, int l) {
    PH_IDS;
    bf16_t* U = c.wsp<bf16_t>(WS_U); const bf16_t* V = c.wsp<bf16_t>(WS_V); const float* vsp = c.wsp<float>(WS_SSP);
    const float* gv = c.in(7) + l * DSGU; const float* wsrc = c.in(8) + (size_t)l * 8 * 128 * 128; const float* bs = c.in(9) + l * 8 * 128;
    LAS unsigned char* lds = c.lds; constexpr int WS_OFF = 65536, RS_OFF = 98304;
    const int lane = lane_, w = wave_, h = lane >> 5, blk = (lane >> 4) & 1, q4 = (lane & 15) >> 2, p = lane & 3;
    for (int item = c.bid; item < 1024; item += c.G) {
        const int g = item & 7, cb = item >> 3; const int row0 = cb * 128;
#pragma unroll
        for (int i = 0; i < 8; ++i) { const int Gq = (i * 8 + w) * 64 + lane, s = Gq >> 5, chp = Gq & 31, ch = chp ^ ((s & 3) << 2);
            __builtin_amdgcn_global_load_lds((const unsigned*)(V + (size_t)(row0 + s) * DSGU + g * 256 + ch * 8), (LAS unsigned*)(lds + (size_t)(i * 8 + w) * 1024), 16, 0, 0); }
        if (tid_ < 128) { float a = 0.f;
#pragma unroll
            for (int k = 0; k < 8; ++k) { const f32x4 pz = *(const f32x4*)(vsp + (size_t)(row0 + tid_) * 32 + 4 * k); a += (pz[0] + pz[1]) + (pz[2] + pz[3]); }
            ((LAS float*)(lds + RS_OFF))[tid_] = rsqrtf(a * (1.0f / DSGU) + EPS); }
        __syncthreads();
        { const int t = tid_ >> 2, sq = tid_ & 3; const float* wr_ = wsrc + ((size_t)g * 128 + t) * 128 + sq * 32; const LAS float* rs = (const LAS float*)(lds + RS_OFF) + sq * 32;
#pragma unroll
            for (int k8 = 0; k8 < 4; ++k8) { const f32x4 a = *(const f32x4*)(wr_ + k8 * 8), b = *(const f32x4*)(wr_ + k8 * 8 + 4); float x[8];
#pragma unroll
                for (int j = 0; j < 4; ++j) { x[j] = a[j]; x[4 + j] = b[j]; }
#pragma unroll
                for (int j = 0; j < 8; ++j) { const int s = sq * 32 + k8 * 8 + j; x[j] = s <= t ? x[j] * rs[k8 * 8 + j] : 0.f; }
                u32x4 wv; wv.x = cvt_pk_bf16(x[0], x[1]); wv.y = cvt_pk_bf16(x[2], x[3]); wv.z = cvt_pk_bf16(x[4], x[5]); wv.w = cvt_pk_bf16(x[6], x[7]);
                *(LAS u32x4*)(lds + WS_OFF + t * 256 + (((sq * 4 + k8) ^ (t & 15)) * 16)) = wv; } }
        asm volatile("s_waitcnt vmcnt(0)" ::: "memory");
        __syncthreads();
        f32x16 acc[4];
#pragma unroll
        for (int tb = 0; tb < 4; ++tb)
#pragma unroll
            for (int r = 0; r < 16; ++r) acc[tb][r] = 0.f;
#pragma unroll
        for (int ks = 0; ks < 8; ++ks) {
            bf16x8 a;
#pragma unroll
            for (int t2 = 0; t2 < 2; ++t2) { const int s = 16 * ks + 8 * h + 4 * t2 + q4; const int ch = (4 * w + 2 * blk + (p >> 1)) ^ ((s & 3) << 2);
                const s16x4 v = __builtin_amdgcn_ds_read_tr16_b64_v4i16((LAS s16x4*)(lds + s * 512 + ch * 16 + 8 * (p & 1)));
                a[4 * t2 + 0] = v[0]; a[4 * t2 + 1] = v[1]; a[4 * t2 + 2] = v[2]; a[4 * t2 + 3] = v[3]; }
#pragma unroll
            for (int tb = 0; tb < 4; ++tb) { if (ks >= 2 * (tb + 1)) continue; const int t = 32 * tb + (lane & 31);
                const bf16x8 b = *(const LAS bf16x8*)(lds + WS_OFF + t * 256 + (((2 * ks + h) ^ (t & 15)) * 16));
                acc[tb] = __builtin_amdgcn_mfma_f32_32x32x16_bf16(a, b, acc[tb], 0, 0, 0); }
        }
#pragma unroll
        for (int tb = 0; tb < 4; ++tb) { const int t = 32 * tb + (lane & 31); const float bias = bs[g * 128 + t]; bf16_t* urow = U + (size_t)(row0 + t) * DSGU + g * 256 + 32 * w + 4 * h;
#pragma unroll
            for (int r = 0; r < 4; ++r) { const f32x4 gg = *(const f32x4*)(gv + g * 256 + 32 * w + 8 * r + 4 * h); const u32x2 uu = *(const u32x2*)(urow + 8 * r);
                const float o0 = bf_lo(uu.x) * (gg[0] * acc[tb][4 * r + 0] + bias), o1 = bf_hi(uu.x) * (gg[1] * acc[tb][4 * r + 1] + bias);
                const float o2 = bf_lo(uu.y) * (gg[2] * acc[tb][4 * r + 2] + bias), o3 = bf_hi(uu.y) * (gg[3] * acc[tb][4 * r + 3] + bias);
                u32x2 o; o.x = cvt_pk_bf16(o0, o1); o.y = cvt_pk_bf16(o2, o3); *(u32x2*)(urow + 8 * r) = o; } }
        __syncthreads();
    }
    const float* slab = c.wsp<float>(WS_SLAB2); const float* ssin = c.ss(2 * l); LAS float* Z = (LAS float*)lds;
    for (int sr = c.bid; sr < MS; sr += c.G) { const int row = MP + sr; const float rstd_h = rsqrtf(ssin[row] * (1.0f / D) + EPS);
        { const int col = tid_ * 8; f32x4 z0 = (f32x4){0.f, 0.f, 0.f, 0.f}, z1 = z0;
#pragma unroll
          for (int k = 0; k < 4; ++k) { const float* sp = slab + ((size_t)k * MS + sr) * 4096 + col; z0 += *(const f32x4*)sp; z1 += *(const f32x4*)(sp + 4); }
#pragma unroll
          for (int i = 0; i < 4; ++i) { z0[i] = gelu_tanh(z0[i] * rstd_h); z1[i] = gelu_tanh(z1[i] * rstd_h); }
          *(LAS f32x4*)(Z + col) = z0; *(LAS f32x4*)(Z + col + 4) = z1; }
        __syncthreads();
        const int col = tid_ * 4, g = col >> 8; const f32x4 uu = *(const LAS f32x4*)(Z + col), vv = *(const LAS f32x4*)(Z + DSGU + col);
        float sq = rsum4(vv);
#pragma unroll
        for (int o = 32; o >= 1; o >>= 1) sq += shfl_xor_l(sq, o, lane_);
        if (lane_ == 0) Z[4096 + wave_] = sq;
        __syncthreads();
        float av = 0.f;
#pragma unroll
        for (int k = 0; k < 8; ++k) av += Z[4096 + k];
        const float rstd = rsqrtf(av * (1.0f / DSGU) + EPS);
        const float w00 = wsrc[(size_t)g * 128 * 128], b0 = bs[g * 128]; const f32x4 gg = *(const f32x4*)(gv + col);
        const f32x4 vn = vv * rstd * gg;
        *(f32x4*)(c.out + O_SGV + ((size_t)l * MS + sr) * DSGU + col) = vn;
        u32x2 o; o.x = cvt_pk_bf16(uu[0] * (w00 * vn[0] + b0), uu[1] * (w00 * vn[1] + b0)); o.y = cvt_pk_bf16(uu[2] * (w00 * vn[2] + b0), uu[3] * (w00 * vn[3] + b0));
        *(u32x2*)(U + (size_t)row * DSGU + col) = o;
        __syncthreads(); }
}

__device__ __forceinline__ void phase_kvfin(const Ctx& c) {
    PH_IDS;
    const float* KVR = c.wsp<float>(WS_KVR); bf16_t* KVb = c.wsp<bf16_t>(WS_KVB); const float* ssp = c.wsp<float>(WS_SSP); const f32x2* rope = c.wsp<f32x2>(WS_ROPE); const float* ln = c.in(16);
    for (int row = c.bid * 8 + wave_; row < MT; row += c.G * 8) {
        const f32x4 pc = *(const f32x4*)(ssp + (size_t)row * 32); const float rstd = rsqrtf(((pc[0] + pc[1]) + (pc[2] + pc[3])) * (1.0f / KVC) + EPS); const int lane = lane_;
        const f32x4 x = *(const f32x4*)(KVR + (size_t)row * QKD + lane * 4), g4 = *(const f32x4*)(ln + lane * 4); const f32x4 y = x * rstd * g4;
        float* oc = row < MP ? c.out + O_KLP + (size_t)row * KVC : c.out + O_KLS + (size_t)(row - MP) * KVC; *(f32x4*)(oc + lane * 4) = y;
        u32x2 w; w.x = cvt_pk_bf16(y[0], y[1]); w.y = cvt_pk_bf16(y[2], y[3]); *(u32x2*)(KVb + (size_t)row * QKD + lane * 4) = w;
        if (lane < 32) { const float x1 = KVR[(size_t)row * QKD + KVC + 2 * lane], x2 = KVR[(size_t)row * QKD + KVC + 2 * lane + 1];
            const int pidx = row < MP ? (row & (SEQ - 1)) : SEQ; const f32x2 cs = rope[pidx * 32 + lane];
            const float o1 = x1 * cs.x - x2 * cs.y, o2 = x2 * cs.x + x1 * cs.y;
            float* ok = row < MP ? c.out + O_KRP + (size_t)row * RD : c.out + O_KRS + (size_t)(row - MP) * RD; ok[lane] = o1; ok[32 + lane] = o2;
            *(unsigned*)(KVb + (size_t)row * QKD + KVC + 2 * lane) = cvt_pk_bf16(o1, o2); } }
}

__device__ __forceinline__ void phase_fix(const Ctx& c, int nkc, int site) {
    PH_IDS;
    bf16_t* Hb = c.wsp<bf16_t>(WS_HB); const float* slab = c.wsp<float>(WS_SLAB); float* ss = c.ss(site);
    for (int r = c.bid * 8 + wave_; r < MS; r += c.G * 8) { float sq = 0.f;
#pragma unroll
        for (int i = 0; i < 4; ++i) { const int col = i * 256 + lane_ * 4; bf16_t* hp = Hb + (size_t)(MP + r) * D + col; const u32x2 b = *(const u32x2*)hp;
            f32x4 h = (f32x4){bf_lo(b.x), bf_hi(b.x), bf_lo(b.y), bf_hi(b.y)};
            for (int k = 0; k < nkc; ++k) h += *(const f32x4*)(slab + ((size_t)k * MS + r) * D + col);
            sq += rsum4(h);
            u32x2 w; w.x = cvt_pk_bf16(h[0], h[1]); w.y = cvt_pk_bf16(h[2], h[3]); *(u32x2*)hp = w; }
#pragma unroll
        for (int o = 32; o >= 1; o >>= 1) sq += shfl_xor_l(sq, o, lane_);
        if (lane_ == 0) ss[MP + r] = sq; }
    const float* ssp = c.wsp<float>(WS_SSP);
    for (int row = c.bid * 512 + tid_; row < MP; row += c.G * 512) { float a = 0.f;
#pragma unroll
        for (int k = 0; k < 4; ++k) { const f32x4 pz = *(const f32x4*)(ssp + (size_t)row * 32 + 4 * k); a += (pz[0] + pz[1]) + (pz[2] + pz[3]); }
        ss[row] = a; }
}

__device__ __forceinline__ void phase_final(const Ctx& c) {
    PH_IDS;
    const bf16_t* Hb = c.wsp<bf16_t>(WS_HB); const float* ssp = c.wsp<float>(WS_SSP); const float* gn = c.in(23); const float* slab = c.wsp<float>(WS_SLAB);
    for (int row = c.bid * 8 + wave_; row < MT; row += c.G * 8) {
        f32x4 h[4]; float sq = 0.f;
#pragma unroll
        for (int i = 0; i < 4; ++i) { const int col = i * 256 + lane_ * 4; const u32x2 b = *(const u32x2*)(Hb + (size_t)row * D + col); h[i] = (f32x4){bf_lo(b.x), bf_hi(b.x), bf_lo(b.y), bf_hi(b.y)};
            if (row >= MP) { for (int k = 0; k < 11; ++k) h[i] += *(const f32x4*)(slab + ((size_t)k * MS + (row - MP)) * D + col); sq += rsum4(h[i]); } }
        if (row >= MP) {
#pragma unroll
            for (int o = 32; o >= 1; o >>= 1) sq += shfl_xor_l(sq, o, lane_);
        } else {
#pragma unroll
            for (int k = 0; k < 4; ++k) { const f32x4 pz = *(const f32x4*)(ssp + (size_t)row * 32 + 4 * k); sq += (pz[0] + pz[1]) + (pz[2] + pz[3]); } }
        const float rstd = rsqrtf(sq * (1.0f / D) + EPS);
        float* o = row < MP ? c.out + O_YP + (size_t)row * D : c.out + O_YS + (size_t)(row - MP) * D;
#pragma unroll
        for (int i = 0; i < 4; ++i) { const int col = i * 256 + lane_ * 4; *(f32x4*)(o + col) = h[i] * rstd * *(const f32x4*)(gn + col); } }
}

#define AT_BAR() do { asm volatile("s_waitcnt lgkmcnt(0)" ::: "memory"); __builtin_amdgcn_s_barrier(); asm volatile("" ::: "memory"); } while (0)

__device__ __forceinline__ int kswz(int row) { return (((row >> 1) & 1) << 2) | ((row >> 2) & 3); }
__device__ __forceinline__ int vswz(int row) { return ((row & 3) << 2) | ((row >> 2) & 3); }
constexpr int A3_KB = 24576, A3_VB = 16384, A3_V0 = 2 * A3_KB;
struct A3Src { unsigned koff[3]; unsigned krope; unsigned voff[2]; };
__device__ __forceinline__ void attn3_issue(LAS unsigned char* lds, const unsigned char* ws, const A3Src& a, int t, int buf, int w) {
#pragma unroll
    for (int i = 0; i < 3; ++i) { const unsigned off = a.koff[i] + (unsigned)t * (((a.krope >> i) & 1u) ? 64u * QKD * 2u : 64u * 128u * 2u);
        __builtin_amdgcn_global_load_lds((const unsigned*)(ws + off), (LAS unsigned*)(lds + buf * A3_KB + (i * 8 + w) * 1024), 16, 0, 0); }
#pragma unroll
    for (int i = 0; i < 2; ++i)
        __builtin_amdgcn_global_load_lds((const unsigned*)(ws + (a.voff[i] + (unsigned)t * (64u * 128u * 2u))), (LAS unsigned*)(lds + A3_V0 + buf * A3_VB + (i * 8 + w) * 1024), 16, 0, 0);
}
template <int BUF>
__device__ __forceinline__ void attn3_tile(LAS unsigned char* lds, const unsigned char* ws, const A3Src& a, int t, int tn, int qw0, int w, int lane,
                                           const bf16x8 (&Qf)[12], f32x16 (&O)[4], float& mref, float& lsum) {
    const int h = lane >> 5, qr = lane & 31, blk16 = (lane >> 4) & 1, q4 = (lane & 15) >> 2, p = lane & 3;
    asm volatile("s_waitcnt vmcnt(0)" ::: "memory");
    AT_BAR();
    if (tn >= 0) attn3_issue(lds, ws, a, tn, BUF ^ 1, w);
    LAS unsigned char* kbuf = lds + BUF * A3_KB; LAS unsigned char* vbuf = lds + A3_V0 + BUF * A3_VB;
    unsigned kl = qr * 384, kx = (h ^ kswz(qr)) * 16, vl = (4 * h + q4) * 256 + 8 * (p & 1), vx = (((2 * blk16 + (p >> 1)) ^ h ^ (q4 << 2))) * 16;
    asm volatile("" : "+v"(kl), "+v"(kx), "+v"(vl), "+v"(vx));
#define A3_LDK(blk, ks) (*(const LAS bf16x8*)(kbuf + (kl + (kx ^ (32u * ((ks) & 3)))) + 128 * ((ks) >> 2) + 32 * (blk) * 384))
#define A3_QKS(blk, S, CHUNK, ks) do { \
              if constexpr ((ks) + RD - 1 < 12) kf[((ks) + RD - 1) % RD] = A3_LDK(blk, (ks) + RD - 1); \
              S = __builtin_amdgcn_mfma_f32_32x32x16_bf16(kf[(ks) % RD], Qf[ks], S, 0, 0, 0); \
              CHUNK(ks); \
              __builtin_amdgcn_sched_barrier(0); } while (0)
#define A3_QK(blk, S, CHUNK, RD_) do { constexpr int RD = RD_; bf16x8 kf[RD]; \
          _Pragma("unroll") for (int r = 0; r < 16; ++r) S[r] = 0.f; \
          _Pragma("unroll") for (int i = 0; i < RD - 1; ++i) kf[i] = A3_LDK(blk, i); \
          __builtin_amdgcn_s_setprio(1); \
          A3_QKS(blk, S, CHUNK, 0); A3_QKS(blk, S, CHUNK, 1); A3_QKS(blk, S, CHUNK, 2); A3_QKS(blk, S, CHUNK, 3); A3_QKS(blk, S, CHUNK, 4); A3_QKS(blk, S, CHUNK, 5); \
          A3_QKS(blk, S, CHUNK, 6); A3_QKS(blk, S, CHUNK, 7); A3_QKS(blk, S, CHUNK, 8); A3_QKS(blk, S, CHUNK, 9); A3_QKS(blk, S, CHUNK, 10); A3_QKS(blk, S, CHUNK, 11); \
          __builtin_amdgcn_s_setprio(0); } while (0)
#define A3_NOCHUNK(ks) do { } while (0)
    const unsigned vb = (unsigned)(size_t)lds + vl + BUF * A3_VB;
#define A3_LDV(blk, dst, i) do { \
            asm volatile("ds_read_b64_tr_b16 %0, %1 offset:%2" : "=&v"(dst[0]) : "v"(vb + (vx ^ (unsigned)(64 * ((i) & 3)))), "n"(A3_V0 + (32 * (blk) + 16 * ((i) >> 2)) * 256)); \
            asm volatile("ds_read_b64_tr_b16 %0, %1 offset:%2" : "=&v"(dst[1]) : "v"(vb + (vx ^ (unsigned)(64 * ((i) & 3) + 32))), "n"(A3_V0 + (32 * (blk) + 16 * ((i) >> 2) + 8) * 256)); } while (0)
#define A3_PVS(blk, P, i) do { \
              if constexpr ((i) + VD - 1 < 8) A3_LDV(blk, vf[((i) + VD - 1) % VD], (i) + VD - 1); \
              asm volatile("s_waitcnt lgkmcnt(%2)" : "+v"(vf[(i) % VD][0]), "+v"(vf[(i) % VD][1]) : "n"((i) + VD - 1 < 8 ? 2 * (VD - 1) : 2 * (7 - (i)))); \
              { u32x4 t4; t4.x = vf[(i) % VD][0].x; t4.y = vf[(i) % VD][0].y; t4.z = vf[(i) % VD][1].x; t4.w = vf[(i) % VD][1].y; \
                O[(i) & 3] = __builtin_amdgcn_mfma_f32_32x32x16_bf16(__builtin_bit_cast(bf16x8, t4), P[(i) >> 2], O[(i) & 3], 0, 0, 0); } \
              __builtin_amdgcn_sched_barrier(0); } while (0)
#define A3_PV(blk, P) do { constexpr int VD = 4; u32x2 vf[VD][2]; \
          A3_LDV(blk, vf[0], 0); A3_LDV(blk, vf[1], 1); A3_LDV(blk, vf[2], 2); \
          __builtin_amdgcn_s_setprio(1); \
          A3_PVS(blk, P, 0); A3_PVS(blk, P, 1); A3_PVS(blk, P, 2); A3_PVS(blk, P, 3); A3_PVS(blk, P, 4); A3_PVS(blk, P, 5); A3_PVS(blk, P, 6); A3_PVS(blk, P, 7); \
          __builtin_amdgcn_s_setprio(0); } while (0)
#define A3_SM(S, P) do { float mx = S[0]; \
        _Pragma("unroll") for (int r = 1; r < 16; ++r) mx = fmaxf(mx, S[r]); \
        mx = fmaxf(mx, shfl_xor_l(mx, 32, lane)); \
        if (__any(mx > mref + 8.0f)) { const float mn = fmaxf(mref, mx), alpha = fast_exp2(mref - mn); \
            _Pragma("unroll") for (int cb = 0; cb < 4; ++cb) \
                _Pragma("unroll") for (int r = 0; r < 16; ++r) O[cb][r] *= alpha; \
            lsum *= alpha; mref = mn; } \
        { float ps = 0.f; unsigned pk[8]; \
          _Pragma("unroll") for (int r = 0; r < 16; r += 2) { const float p0 = fast_exp2(S[r] - mref), p1 = fast_exp2(S[r + 1] - mref); ps += p0 + p1; pk[r >> 1] = cvt_pk_bf16(p0, p1); } \
          lsum += ps; \
          _Pragma("unroll") for (int s2 = 0; s2 < 2; ++s2) { u32x4 t4; t4.x = pk[4 * s2]; t4.y = pk[4 * s2 + 1]; t4.z = pk[4 * s2 + 2]; t4.w = pk[4 * s2 + 3]; P[s2] = __builtin_bit_cast(bf16x8, t4); } } } while (0)
#define A3_BLOCK(blk) do { f32x16 S; bf16x8 P[2]; \
        A3_QK(blk, S, A3_NOCHUNK, 5); \
        if (64 * t + 32 * (blk) == qw0) {             \
            _Pragma("unroll") for (int r = 0; r < 16; ++r) { const int key = (r & 3) + 8 * (r >> 2) + 4 * h; if (key > qr) S[r] = -1e30f; } } \
        A3_SM(S, P); \
        A3_PV(blk, P); } while (0)
    if (64 * t <= qw0 + 31) {
        A3_BLOCK(0);
        if (64 * t + 32 <= qw0 + 31) A3_BLOCK(1);
    }
#undef A3_BLOCK
#undef A3_PVS
#undef A3_LDK
#undef A3_QK
#undef A3_QKS
#undef A3_NOCHUNK
#undef A3_LDV
#undef A3_PV
#undef A3_SM
}
template <int rev> __device__ __forceinline__ void attn3_item(const Ctx& c, int b, int head, int qblk) {
    PH_IDS;
    const bf16_t* QH = c.wsp<bf16_t>(WS_QH); bf16_t* OV = c.wsp<bf16_t>(WS_OV);
    LAS unsigned char* lds = c.lds; const int lane = lane_, w = wave_, h = lane >> 5, qr = lane & 31;
    const int qw0 = 256 * qblk + 32 * w, nt = 4 * (qblk + 1);
    static_assert(WS_END < (size_t)4 << 30, "32-bit workspace offsets");
    const unsigned kn0 = (unsigned)(WS_KN + (size_t)(b * NH + head) * SEQ * 128 * 2), vh0 = (unsigned)(WS_VH + (size_t)(b * NH + head) * SEQ * 128 * 2), kr0 = (unsigned)(WS_KVB + ((size_t)b * SEQ * QKD + KVC) * 2);
    A3Src a; a.krope = 0u;
#pragma unroll
    for (int i = 0; i < 3; ++i) { const int Gq = (i * 8 + w) * 64 + lane, r = Gq / 24, chp = Gq - r * 24, ch = chp ^ kswz(r);
        if (ch < 16) a.koff[i] = kn0 + (unsigned)(r * 128 + ch * 8) * 2u; else { a.koff[i] = kr0 + (unsigned)(r * QKD + (ch - 16) * 8) * 2u; a.krope |= 1u << i; } }
#pragma unroll
    for (int i = 0; i < 2; ++i) { const int Gq = (i * 8 + w) * 64 + lane, r = Gq >> 4, chp = Gq & 15, ch = chp ^ vswz(r); a.voff[i] = vh0 + (unsigned)(r * 128 + ch * 8) * 2u; }
    AT_BAR();
    constexpr int step = rev ? -1 : 1; int t = rev ? nt - 1 : 0;
    attn3_issue(lds, c.ws, a, t, 0, w);
    bf16x8 Qf[12];
    { const bf16_t* qrow = QH + ((size_t)b * SEQ + qw0 + qr) * 3072 + head * 192 + 8 * h;
#pragma unroll
      for (int ks = 0; ks < 12; ++ks) Qf[ks] = *(const bf16x8*)(qrow + 16 * ks); }
    f32x16 O[4];
#pragma unroll
    for (int cb = 0; cb < 4; ++cb)
#pragma unroll
        for (int r = 0; r < 16; ++r) O[cb][r] = 0.f;
    float mref = -1e30f, lsum = 0.f;
    for (int i = 0; i < nt; i += 2, t += 2 * step) {
        attn3_tile<0>(lds, c.ws, a, t, t + step, qw0, w, lane, Qf, O, mref, lsum);
        attn3_tile<1>(lds, c.ws, a, t + step, i + 2 < nt ? t + 2 * step : -1, qw0, w, lane, Qf, O, mref, lsum);
    }
    lsum += shfl_xor_l(lsum, 32, lane);
    const float inv = 1.0f / lsum;
    bf16_t* orow = OV + ((size_t)b * SEQ + qw0 + qr) * 2048 + head * 128 + 8 * h;
#pragma unroll
    for (int cb = 0; cb < 4; ++cb)
#pragma unroll
        for (int j = 0; j < 2; ++j) { u32x2 ga, gb;
            ga.x = cvt_pk_bf16(O[cb][8 * j] * inv, O[cb][8 * j + 1] * inv); ga.y = cvt_pk_bf16(O[cb][8 * j + 2] * inv, O[cb][8 * j + 3] * inv);
            gb.x = cvt_pk_bf16(O[cb][8 * j + 4] * inv, O[cb][8 * j + 5] * inv); gb.y = cvt_pk_bf16(O[cb][8 * j + 6] * inv, O[cb][8 * j + 7] * inv);
            { const auto r = __builtin_amdgcn_permlane32_swap(ga.x, gb.x, false, false); ga.x = r[0]; gb.x = r[1]; }
            { const auto r = __builtin_amdgcn_permlane32_swap(ga.y, gb.y, false, false); ga.y = r[0]; gb.y = r[1]; }
            *(u32x4*)(orow + 32 * cb + 16 * j) = (u32x4){ga.x, ga.y, gb.x, gb.y}; }
}

__device__ __forceinline__ void attn_pair(const Ctx& c, int pr) {
    const int b = pr & 7, head = (pr >> 3) & 15, x = pr >> 7;
    for (int k = 0; k < 2; ++k) attn3_item<0>(c, b, head, k ? x : 7 - x);
}

template <int SUB, int PASS> __device__ __forceinline__ void dec_load_half(f32x4 (&R)[12], const float* const (&pkv)[4], const float* const (&pkr)[4], const unsigned char* cp, int hh, int hd, int g, int lane) {
    const int tt = hh >> 1, pi = tt >> 3, key0 = (tt & 7) * 16;
    const float* kc = (pi == 0 ? pkv[0] : pi == 1 ? pkv[1] : pi == 2 ? pkv[2] : pkv[3]) + (size_t)(key0 + 8 * SUB) * KVC + 4 * lane;
#pragma unroll
    for (int r = 0; r < 8; ++r) R[r] = *((const f32x4*)(kc + r * KVC));
    if (SUB == 1) {
        const float* kr = (pi == 0 ? pkr[0] : pi == 1 ? pkr[1] : pi == 2 ? pkr[2] : pkr[3]) + (size_t)(key0 + hd) * RD + 8 * g;
        R[8] = *((const f32x4*)kr); R[9] = *((const f32x4*)(kr + 4)); R[10] = *((const f32x4*)(kr + 32)); R[11] = *((const f32x4*)(kr + 36));
    }
}
template <int T, int sub, int PASS> __device__ __forceinline__ void dec_compute_half(const f32x4 (&R)[12], f32x4 (&S)[2], LAS unsigned char* vt, const LAS unsigned char* qs, unsigned char* cp, int tt, int hd, int g, int lane) {
#pragma unroll
    for (int r = 0; r < 8; ++r) { const int row = 16 * T + 8 * sub + r; const f32x4 x = R[r];
        u32x2 w; w.x = cvt_pk_bf16(x[0], x[1]); w.y = cvt_pk_bf16(x[2], x[3]);
        *(LAS u32x2*)(vt + row * 512 + (((lane >> 1) ^ ((row & 7) << 1)) * 16) + 8 * (lane & 1)) = w;
        if ((r & 3) == 3) __builtin_amdgcn_sched_barrier(0); }
    if (sub == 1) {
        const int vrow = 16 * T + hd; f32x4 s4 = (f32x4){0.f, 0.f, 0.f, 0.f};
#pragma unroll
        for (int ks = 0; ks < 10; ++ks) { u32x4 a4; int w0, w1;
            if (ks < 8) { a4 = *(const LAS u32x4*)(vt + vrow * 512 + (((4 * ks + g) ^ ((vrow & 7) << 1)) * 16));
                w0 = __builtin_amdgcn_cvt_pk_fp8_f32(__uint_as_float(a4.x << 16), __uint_as_float(a4.x & 0xffff0000u), 0, false);
                w0 = __builtin_amdgcn_cvt_pk_fp8_f32(__uint_as_float(a4.y << 16), __uint_as_float(a4.y & 0xffff0000u), w0, true);
                w1 = __builtin_amdgcn_cvt_pk_fp8_f32(__uint_as_float(a4.z << 16), __uint_as_float(a4.z & 0xffff0000u), 0, false);
                w1 = __builtin_amdgcn_cvt_pk_fp8_f32(__uint_as_float(a4.w << 16), __uint_as_float(a4.w & 0xffff0000u), w1, true); }
            else { const f32x4 x0 = R[8 + 2 * (ks - 8)], x1 = R[9 + 2 * (ks - 8)];
                a4.x = cvt_pk_bf16(x0[0], x0[1]); a4.y = cvt_pk_bf16(x0[2], x0[3]); a4.z = cvt_pk_bf16(x1[0], x1[1]); a4.w = cvt_pk_bf16(x1[2], x1[3]);
                w0 = __builtin_amdgcn_cvt_pk_fp8_f32(x0[0], x0[1], 0, false); w0 = __builtin_amdgcn_cvt_pk_fp8_f32(x0[2], x0[3], w0, true);
                w1 = __builtin_amdgcn_cvt_pk_fp8_f32(x1[0], x1[1], 0, false); w1 = __builtin_amdgcn_cvt_pk_fp8_f32(x1[2], x1[3], w1, true); }
            *(u32x2*)(cp + ((size_t)(tt * 10 + ks) * 512 + lane * 8)) = (u32x2){(unsigned)w0, (unsigned)w1};
            const bf16x8 qv = *(const LAS bf16x8*)(qs + ks * 1024 + lane * 16);
            s4 = __builtin_amdgcn_mfma_f32_16x16x32_bf16(__builtin_bit_cast(bf16x8, a4), qv, s4, 0, 0, 0);
            if ((ks & 1) == 1) __builtin_amdgcn_sched_barrier(0); }
        S[T] = s4;
    }
}
__device__ __forceinline__ void dec_softmax_pv(const f32x4 (&S)[2], f32x4 (&O)[16], float& mref, float& lsum, const LAS unsigned char* vt, int g, int q4, int p, int lane) {
    float mx = fmaxf(fmaxf(fmaxf(S[0][0], S[0][1]), fmaxf(S[0][2], S[0][3])), fmaxf(fmaxf(S[1][0], S[1][1]), fmaxf(S[1][2], S[1][3])));
    mx = fmaxf(mx, shfl_xor_l(mx, 16, lane)); mx = fmaxf(mx, shfl_xor_l(mx, 32, lane));
    if (__any(mx > mref + 8.0f)) { const float mn = fmaxf(mref, mx), alpha = fast_exp2(mref - mn);
#pragma unroll
        for (int cb = 0; cb < 16; ++cb) O[cb] *= alpha;
        lsum *= alpha; mref = mn; }
    float pv[8];
#pragma unroll
    for (int i = 0; i < 4; ++i) { pv[i] = fast_exp2(S[0][i] - mref); pv[4 + i] = fast_exp2(S[1][i] - mref); }
    lsum += ((pv[0] + pv[1]) + (pv[2] + pv[3])) + ((pv[4] + pv[5]) + (pv[6] + pv[7]));
    u32x4 p4; p4.x = cvt_pk_bf16(pv[0], pv[1]); p4.y = cvt_pk_bf16(pv[2], pv[3]); p4.z = cvt_pk_bf16(pv[4], pv[5]); p4.w = cvt_pk_bf16(pv[6], pv[7]);
    const bf16x8 P = __builtin_bit_cast(bf16x8, p4);
#pragma unroll
    for (int cb = 0; cb < 16; ++cb) { bf16x8 a;
#pragma unroll
        for (int t2 = 0; t2 < 2; ++t2) { const int vr = 16 * t2 + 4 * g + q4; const int ch = (2 * cb + (p >> 1)) ^ ((vr & 7) << 1);
            const s16x4 v = __builtin_amdgcn_ds_read_tr16_b64_v4i16((LAS s16x4*)(vt + vr * 512 + ch * 16 + 8 * (p & 1)));
            a[4 * t2 + 0] = v[0]; a[4 * t2 + 1] = v[1]; a[4 * t2 + 2] = v[2]; a[4 * t2 + 3] = v[3]; }
        O[cb] = __builtin_amdgcn_mfma_f32_16x16x32_bf16(a, P, O[cb], 0, 0, 0);
        if ((cb & 1) == 1) __builtin_amdgcn_sched_barrier(0); }
}

typedef float f32x2v __attribute__((ext_vector_type(2)));
__device__ __forceinline__ void dec_load_tile1(u32x2 (&R)[10], const unsigned char* cp, int tt, int lane) {
#pragma unroll
    for (int k = 0; k < 10; ++k) R[k] = *(const u32x2*)(cp + ((size_t)(tt * 10 + k) * 512 + lane * 8));
}
template <int T> __device__ __forceinline__ void dec_compute_tile1(const u32x2 (&R)[10], f32x4 (&S)[2], LAS unsigned char* vt, const LAS unsigned char* qs, int hd, int g, int lane) {
    const int vrow = 16 * T + hd; f32x4 s4 = (f32x4){0.f, 0.f, 0.f, 0.f};
#pragma unroll
    for (int ks = 0; ks < 10; ++ks) { const int wx = (int)R[ks].x, wy = (int)R[ks].y;
        const f32x2v f0 = __builtin_amdgcn_cvt_pk_f32_fp8(wx, false), f1 = __builtin_amdgcn_cvt_pk_f32_fp8(wx, true), f2 = __builtin_amdgcn_cvt_pk_f32_fp8(wy, false), f3 = __builtin_amdgcn_cvt_pk_f32_fp8(wy, true);
        u32x4 a4; a4.x = cvt_pk_bf16(f0[0], f0[1]); a4.y = cvt_pk_bf16(f1[0], f1[1]); a4.z = cvt_pk_bf16(f2[0], f2[1]); a4.w = cvt_pk_bf16(f3[0], f3[1]);
        const bf16x8 qv = *(const LAS bf16x8*)(qs + ks * 1024 + lane * 16);
        s4 = __builtin_amdgcn_mfma_f32_16x16x32_bf16(__builtin_bit_cast(bf16x8, a4), qv, s4, 0, 0, 0);
        if (ks < 8) *(LAS u32x4*)(vt + vrow * 512 + (((4 * ks + g) ^ ((vrow & 7) << 1)) * 16)) = a4;
        if ((ks & 1) == 1) __builtin_amdgcn_sched_barrier(0); }
    S[T] = s4;
}

template <int PASS> __device__ __forceinline__ void decode_item(const Ctx& c, int j, int it) {
    PH_IDS;
    const bf16_t* QF = c.wsp<bf16_t>(WS_QF); bf16_t* OL = c.wsp<bf16_t>(WS_OL); float* PO = c.wsp<float>(WS_PO); float* PML = c.wsp<float>(WS_PML);
    unsigned* cnt = c.wsp<unsigned>(WS_CNT) + j * 128; const float* ckv = c.in(2); const float* ckr = c.in(3); const int* ptab = (const int*)c.in(4);
    LAS unsigned char* lds = c.lds; const int lane = lane_, w = wave_, hd = lane & 15, g = lane >> 4, q4 = (lane & 15) >> 2, p = lane & 3;
    constexpr int DQ_OFF = 131072 + 4096;
    {
        const int seq = it >> 1, half = it & 1, row = MP + seq;
        __syncthreads();
        for (int ks = w; ks < 10; ks += 8) *(LAS u32x4*)(lds + DQ_OFF + ks * 1024 + lane * 16) = *(const u32x4*)(QF + (size_t)row * NQ + hd * QKD + 32 * ks + 8 * g);
        f32x4 O[16];
#pragma unroll
        for (int cb = 0; cb < 16; ++cb) O[cb] = (f32x4){0.f, 0.f, 0.f, 0.f};
        float mref = -1e30f, lsum = 0.f;
        LAS unsigned char* vt = lds + w * 16384; const LAS unsigned char* qs = lds + DQ_OFF;
        unsigned char* cp = c.ws + WS_KC + ((size_t)it * 8 + w) * (32 * 10 * 512);
        const float* pkv[4]; const float* pkr[4];
#pragma unroll
        for (int pi = 0; pi < 4; ++pi) { const int phys = ptab[seq * NPAGES + half * 32 + w * 4 + pi]; pkv[pi] = ckv + (size_t)phys * 128 * KVC; pkr[pi] = ckr + (size_t)phys * 128 * RD; }
        __syncthreads();
        f32x4 R0[12], R1[12]; f32x4 S[2];
        S[0] = (f32x4){0.f, 0.f, 0.f, 0.f}; S[1] = S[0];
        if (PASS == 0) {
            dec_load_half<0, PASS>(R0, pkv, pkr, cp, 0, hd, g, lane);
#define DEC_STEP(i, RC, RN) do { const int hh = h0 + (i); if (hh + 1 < 64) dec_load_half<((i) + 1) & 1, PASS>(RN, pkv, pkr, cp, hh + 1, hd, g, lane); __builtin_amdgcn_sched_barrier(0); \
            dec_compute_half<((i) >> 1) & 1, (i) & 1, PASS>(RC, S, vt, qs, cp, hh >> 1, hd, g, lane); if (((i) & 3) == 3) dec_softmax_pv(S, O, mref, lsum, vt, g, q4, p, lane); __builtin_amdgcn_sched_barrier(0); } while (0)
            for (int h0 = 0; h0 < 64; h0 += 4) { DEC_STEP(0, R0, R1); DEC_STEP(1, R1, R0); DEC_STEP(2, R0, R1); DEC_STEP(3, R1, R0); }
        } else {
            u32x2 Q0[10], Q1[10];
            dec_load_tile1(Q0, cp, 0, lane);
#define DEC_STEP1(i, RC, RN) do { const int tt = t0 + (i); if (tt + 1 < 32) dec_load_tile1(RN, cp, tt + 1, lane); __builtin_amdgcn_sched_barrier(0); \
            dec_compute_tile1<(i) & 1>(RC, S, vt, qs, hd, g, lane); if ((i) == 1) dec_softmax_pv(S, O, mref, lsum, vt, g, q4, p, lane); __builtin_amdgcn_sched_barrier(0); } while (0)
            for (int t0 = 0; t0 < 32; t0 += 2) { DEC_STEP1(0, Q0, Q1); DEC_STEP1(1, Q1, Q0); }
#undef DEC_STEP1
        }
#undef DEC_STEP
        lsum += shfl_xor_l(lsum, 16, lane); lsum += shfl_xor_l(lsum, 32, lane);
        const int tid2 = opaque_tid(c.wv), lane2 = tid2 & 63, w2 = __builtin_amdgcn_readfirstlane(tid2 >> 6), hd2 = lane2 & 15, g2 = lane2 >> 4;
        asm volatile("s_waitcnt lgkmcnt(0)" ::: "memory");
#pragma unroll
        for (int cb = 0; cb < 16; ++cb)
#pragma unroll
            for (int r = 0; r < 4; ++r) ((LAS float*)(lds + w2 * 16384))[(cb * 4 + r) * 64 + lane2] = O[cb][r];
        if (g2 == 0) *(LAS f32x2*)(lds + 131072 + (w2 * 16 + hd2) * 8) = (f32x2){mref, lsum};
        __syncthreads();
        { float mv[8], M = -1e30f;
#pragma unroll
            for (int v = 0; v < 8; ++v) { mv[v] = (*(const LAS f32x2*)(lds + 131072 + (v * 16 + hd2) * 8)).x; M = fmaxf(M, mv[v]); }
            float L = 0.f, sc[8];
#pragma unroll
            for (int v = 0; v < 8; ++v) { sc[v] = fast_exp2(mv[v] - M); L += (*(const LAS f32x2*)(lds + 131072 + (v * 16 + hd2) * 8)).y * sc[v]; }
#pragma unroll
            for (int q = 0; q < 2; ++q) { const int cb = 2 * w2 + q; f32x4 o = (f32x4){0.f, 0.f, 0.f, 0.f};
#pragma unroll
                for (int v = 0; v < 8; ++v)
#pragma unroll
                    for (int r = 0; r < 4; ++r) o[r] += ((const LAS float*)(lds + v * 16384))[(cb * 4 + r) * 64 + lane2] * sc[v];
                *(f32x4*)(PO + ((size_t)it * 16 + hd2) * KVC + 16 * cb + 4 * g2) = o; }
            if (w2 == 0 && g2 == 0) *(f32x2*)(PML + ((size_t)it * 16 + hd2) * 2) = (f32x2){M, L}; }
        asm volatile("s_waitcnt vmcnt(0)" ::: "memory");
        __syncthreads();
        LAS unsigned* flag = (LAS unsigned*)(lds + 131072 + 2048);
        if (tid2 == 0) { __builtin_amdgcn_fence(__ATOMIC_RELEASE, "agent"); asm volatile("s_waitcnt vmcnt(0)" ::: "memory");
            const unsigned old = __hip_atomic_fetch_add(cnt + seq, 1u, __ATOMIC_RELAXED, __HIP_MEMORY_SCOPE_AGENT);
            if (old == 1u) { __builtin_amdgcn_fence(__ATOMIC_ACQUIRE, "agent"); asm volatile("s_waitcnt vmcnt(0)" ::: "memory"); }
            flag[0] = old; }
        __syncthreads();
        if (flag[0] == 1u) {
            const float* cn = c.out + O_KLS + (size_t)seq * KVC; const float* kn = c.out + O_KRS + (size_t)seq * RD;
            LAS float* sself = (LAS float*)(lds + 131072 + 2304);
#pragma unroll
            for (int q = 0; q < 2; ++q) { const int hh = 2 * w2 + q; const bf16_t* qh = QF + (size_t)row * NQ + hh * QKD; float s = 0.f;
#pragma unroll
                for (int i = 0; i < 5; ++i) { const int d = lane2 + 64 * i; const float kvv = d < KVC ? cn[d] : kn[d - KVC]; s += __uint_as_float((unsigned)qh[d] << 16) * kvv; }
#pragma unroll
                for (int o = 32; o >= 1; o >>= 1) s += shfl_xor_l(s, o, lane2);
                if (lane2 == 0) sself[hh] = s; }
            __syncthreads();
            const int idx = tid2 * 8, hh = idx >> 8, cc = idx & 255; const int ia = seq * 2, ib = seq * 2 + 1;
            const f32x2 ma = *(const f32x2*)(PML + ((size_t)ia * 16 + hh) * 2), mb = *(const f32x2*)(PML + ((size_t)ib * 16 + hh) * 2); const float ssf = sself[hh];
            const float M = fmaxf(fmaxf(ma.x, mb.x), ssf), ea = fast_exp2(ma.x - M), eb = fast_exp2(mb.x - M), es = fast_exp2(ssf - M), inv = 1.0f / (ma.y * ea + mb.y * eb + es);
            float o[8];
#pragma unroll
            for (int q = 0; q < 2; ++q) { const f32x4 xa = *(const f32x4*)(PO + ((size_t)ia * 16 + hh) * KVC + cc + 4 * q), xb = *(const f32x4*)(PO + ((size_t)ib * 16 + hh) * KVC + cc + 4 * q), xc = *(const f32x4*)(cn + cc + 4 * q);
#pragma unroll
                for (int i = 0; i < 4; ++i) o[4 * q + i] = (xa[i] * ea + xb[i] * eb + xc[i] * es) * inv; }
            u32x4 wv; wv.x = cvt_pk_bf16(o[0], o[1]); wv.y = cvt_pk_bf16(o[2], o[3]); wv.z = cvt_pk_bf16(o[4], o[5]); wv.w = cvt_pk_bf16(o[6], o[7]);
            *(u32x4*)(OL + (size_t)row * 4096 + hh * KVC + cc) = wv;
        }
    }
}

template <int PASS> __device__ __forceinline__ void phase_attn(const Ctx& c, int j) {
    if (c.G == 256) {
        const int b = c.bid & 7, k = (c.bid >> 3) & 7, team = c.bid >> 6, dslot = (4 * b + team) % 3; int r = 0;
        for (int slot = 0; slot < 3; ++slot) {
            if (slot == dslot) decode_item<PASS>(c, j, c.bid);
            else { attn3_item<0>(c, b, 4 * team + r, k); attn3_item<1>(c, b, 4 * team + r + 1, 7 - k); r += 2; }
        }
        return;
    }
    int pr = c.bid; const int dslot = (c.bid & 127) % 3;
    for (int slot = 0; slot < 3; ++slot) {
        if (slot == dslot) { for (int it = c.bid; it < 256; it += c.G) decode_item<PASS>(c, j, it); }
        else if (pr < 512) { attn_pair(c, pr); pr += c.G; }
    }
    for (; pr < 512; pr += c.G) attn_pair(c, pr);
}
__device__ __forceinline__ void phase_attn_prompt(const Ctx& c) { for (int pr = c.bid; pr < 512; pr += c.G) attn_pair(c, pr); }
__device__ __forceinline__ void phase_attn_decode(const Ctx& c, int j) { for (int it = c.bid; it < 256; it += c.G) decode_item<0>(c, j, it); }

struct Args { const void* in[24]; float* out; unsigned char* ws; int ph_lo, ph_hi; };
enum { K_KVUP = 50, K_PRO = 0, K_ABS, K_SGU, K_MIX, K_RES_SGU, K_FFN_IN, K_FFN_OUT, K_KVQ, K_KVFIN, K_DQ1, K_Q, K_ATTN, K_UV, K_WO, K_FINAL, K_FIX_MID, K_FIX_OUT, K_ATTN_P, K_ATTN_D };

template <int KIND> __device__ __forceinline__ void run_phase(const Ctx& c, int l) {
    LAS unsigned char* lds = c.lds; bf16_t* Hb = c.wsp<bf16_t>(WS_HB);
    const int j = l - 2, s_in = 2 * l, s_mid = 2 * l + 1, s_out = 2 * l + 2;
    if constexpr (KIND == K_PRO) phase_prologue(c);
    if constexpr (KIND == K_ABS) { pg8::Gemm g{c.wsp<bf16_t>(WS_UKP), c.wsp<bf16_t>(WS_UQP), 256, 256, 256}; OrderAbs S{c.G, c.bid}; EpiAbs E{c.wsp<bf16_t>(WS_WQ)}; pg8::gemm_phase(lds, g, S, E, c.wv); }
    if constexpr (KIND == K_SGU) { pg8::Gemm g{Hb, c.wsp<bf16_t>(WS_W1) + (size_t)l * 4096 * D, D, D, D}; OrderRes S; S.init(16, D / 256, c.G, c.bid);
        EpiSgu E{c.ss(s_in), c.wsp<bf16_t>(WS_U), c.wsp<bf16_t>(WS_V), c.wsp<float>(WS_SSP), c.wsp<float>(WS_SLAB2)}; pg8::gemm_phase(lds, g, S, E, c.wv); }
    if constexpr (KIND == K_MIX) phase_mix(c, l);
    if constexpr (KIND == K_RES_SGU) { pg8::Gemm g{c.wsp<bf16_t>(WS_U), c.wsp<bf16_t>(WS_W3) + (size_t)l * D * DSGU, DSGU, DSGU, DSGU}; OrderRes S; S.init(4, DSGU / 256, c.G, c.bid);
        EpiRes E{Hb, c.wsp<float>(WS_SSP), c.wsp<float>(WS_SLAB), Hb}; pg8::gemm_phase(lds, g, S, E, c.wv);
        { const int F = c.G > 32 ? 32 : 0; if (c.bid >= F) { if (l == 0) fill_wo(c, c.bid - F, c.G - F); else fill_q(c, c.bid - F, c.G - F); } } }
    if constexpr (KIND == K_FIX_MID) phase_fix(c, l < 2 ? DSGU / 256 : 2048 / 256, s_mid);
    if constexpr (KIND == K_FIX_OUT) phase_fix(c, DFF / 256, s_out);
    if constexpr (KIND == K_FFN_IN) { pg8::Gemm g{Hb, c.wsp<bf16_t>(WS_W4) + (size_t)l * 2 * DFF * D, D, D, D}; pg8::OrderMN S; S.init(NPAN, 22, c.G, c.bid);
        EpiFfn E{c.ss(s_mid), c.wsp<bf16_t>(WS_F)}; pg8::gemm_phase(lds, g, S, E, c.wv);
        { const int F = c.G > 150 ? 150 : 0; if (l < 3 && c.bid >= F) conv_ffn_w(c, l + 1, c.bid - F, c.G - F); } }
    if constexpr (KIND == K_FFN_OUT) { pg8::Gemm g{c.wsp<bf16_t>(WS_F), c.wsp<bf16_t>(WS_W5) + (size_t)l * D * DFF, DFF, DFF, DFF}; OrderRes S; S.init(4, DFF / 256, c.G, c.bid);
        EpiRes E{Hb, c.wsp<float>(WS_SSP), c.wsp<float>(WS_SLAB), Hb}; pg8::gemm_phase(lds, g, S, E, c.wv);
        { const int F = c.G > 44 ? 44 : 0; if (c.bid >= F) { if (l == 0) conv_sgu_w(c, 1, c.bid - F, c.G - F); else if (l == 1) fill_misc(c, c.bid - F, c.G - F); } } }
    if constexpr (KIND == K_KVQ) { { pg8::Gemm g{Hb, c.wsp<bf16_t>(WS_WKVQ), D, D, D}; pg8::OrderMN S; S.init(NPAN, 3, c.G, c.bid);
        EpiKvq E{c.ss(s_in), c.wsp<float>(WS_KVR), c.wsp<float>(WS_SSP), c.wsp<bf16_t>(WS_CQ), KVC, QKD, QKD + QLR}; pg8::gemm_phase(lds, g, S, E, c.wv); }
        { pg8::Gemm g{c.wsp<bf16_t>(WS_UKP), c.wsp<bf16_t>(WS_UQP), 256, 256, 256}; OrderAbs S{c.G, c.G - 1 - c.bid}; EpiAbs E{c.wsp<bf16_t>(WS_WQ)}; pg8::gemm_phase(lds, g, S, E, c.wv); } }
    if constexpr (KIND == K_KVFIN) phase_kvfin(c);
    if constexpr (KIND == K_DQ1) { pg8::Gemm g{Hb, c.wsp<bf16_t>(WS_WDQ1), D, D, D}; pg8::OrderMN S; S.init(NPAN, 2, c.G, c.bid);
        EpiKvq E{c.ss(s_in), c.wsp<float>(WS_KVR), c.wsp<float>(WS_SSP), c.wsp<bf16_t>(WS_CQ), 0, 0, QLR}; pg8::gemm_phase(lds, g, S, E, c.wv); }
    if constexpr (KIND == K_Q) { if (j == 0) phase_kvfin(c);
        pg8::Gemm g{c.wsp<bf16_t>(WS_CQ), c.wsp<bf16_t>(WS_WQS) + (size_t)j * 3072 * QLR, QLR, QLR, QLR}; OrderQ2 S; S.init(c.wsp<bf16_t>(WS_WQ) + (size_t)j * NQ * QLR, c.G, c.bid);
        EpiQ E{c.wsp<float>(WS_SSP), c.wsp<bf16_t>(WS_QF), c.wsp<f32x2>(WS_ROPE), c.wsp<bf16_t>(WS_QH)}; pg8::gemm_phase(lds, g, S, E, c.wv); }
    if constexpr (KIND == K_KVUP) { pg8::Gemm g{c.wsp<bf16_t>(WS_KVB), c.wsp<bf16_t>(WS_WKV2), QKD, KVC, KVC}; pg8::OrderMN S; S.init(64, 16, c.G, c.bid);
        EpiKvup E{c.wsp<bf16_t>(WS_KN), c.wsp<bf16_t>(WS_VH)}; pg8::gemm_phase(lds, g, S, E, c.wv); }
    if constexpr (KIND == K_ATTN) { if (j == 0) phase_attn<0>(c, j); else phase_attn<1>(c, j); }
    if constexpr (KIND == K_ATTN_P) phase_attn_prompt(c);
    if constexpr (KIND == K_ATTN_D) phase_attn_decode(c, j);
    if constexpr (KIND == K_UV) { pg8::Gemm g{c.wsp<bf16_t>(WS_OL), c.wsp<bf16_t>(WS_WUV), 4096, 512, 512}; OrderUvS S{c.G, c.bid};
        EpiPlain E{c.wsp<bf16_t>(WS_OV), 2048}; pg8::gemm_phase(lds, g, S, E, c.wv); }
    if constexpr (KIND == K_WO) { pg8::Gemm g{c.wsp<bf16_t>(WS_OV), c.wsp<bf16_t>(WS_WO) + (size_t)j * D * 2048, 2048, 2048, 2048}; OrderRes S; S.init(4, 2048 / 256, c.G, c.bid);
        EpiRes E{Hb, c.wsp<float>(WS_SSP), c.wsp<float>(WS_SLAB), Hb}; pg8::gemm_phase(lds, g, S, E, c.wv); }
    if constexpr (KIND == K_FINAL) phase_final(c);
}

constexpr int N_PHASES = 34;
struct Prog { int kind[N_PHASES]; int layer[N_PHASES]; };
__host__ __device__ constexpr Prog make_prog() {
    Prog p{}; int n = 0;
    p.kind[n] = K_PRO; p.layer[n++] = 0;
    for (int l = 0; l < 4; ++l) {
        if (l < 2) { const int ks[4] = {K_SGU, K_MIX, K_RES_SGU, K_FIX_MID}; for (int i = 0; i < 4; ++i) { p.kind[n] = ks[i]; p.layer[n++] = l; } }
        else { if (l == 2) { p.kind[n] = K_KVQ; p.layer[n++] = l; } else { p.kind[n] = K_DQ1; p.layer[n++] = l; }
            p.kind[n] = K_Q; p.layer[n++] = l; if (l == 2) { p.kind[n] = K_KVUP; p.layer[n++] = l; }
            const int ks[4] = {K_ATTN, K_UV, K_WO, K_FIX_MID}; for (int i = 0; i < 4; ++i) { p.kind[n] = ks[i]; p.layer[n++] = l; } }
        p.kind[n] = K_FFN_IN; p.layer[n++] = l; p.kind[n] = K_FFN_OUT; p.layer[n++] = l;
        if (l < 3) { p.kind[n] = K_FIX_OUT; p.layer[n++] = l; }
    }
    p.kind[n] = K_FINAL; p.layer[n++] = 3;
    return p;
}
constexpr Prog PROG = make_prog();
__host__ __device__ constexpr int prog_kind(int p) { return PROG.kind[p]; }
__host__ __device__ constexpr int prog_layer(int p) { return PROG.layer[p]; }
static_assert(PROG.kind[N_PHASES - 1] == K_FINAL, "phase count");

__device__ __forceinline__ void make_ctx(Ctx& c, const Args& args, unsigned char* lds_raw) {
    c.out = args.out; c.ws = args.ws; c.lds = (LAS unsigned char*)lds_raw; c.G = gridDim.x; c.bid = blockIdx.x; c.wv = __builtin_amdgcn_readfirstlane((int)threadIdx.x >> 6);
}

template <int KIND> __global__ void __launch_bounds__(512, 2) k_phase(Args args) {
    extern __shared__ __attribute__((aligned(16))) unsigned char lds_raw[];
    Ctx c; make_ctx(c, args, lds_raw);
    run_phase<KIND>(c, args.ph_lo);
}

#if MK_LAUNCHES == 1
template <int P> __device__ __forceinline__ void run_all(const Ctx& c, const XcdBarrier& bar) {
    if constexpr (P < N_PHASES) {
        run_phase<prog_kind(P)>(c, prog_layer(P));
#ifdef PROBE_DUP
        if constexpr (prog_kind(P) == PROBE_DUP) { xcd_barrier(bar); run_phase<PROBE_DUP_AS>(c, prog_layer(P)); }
#endif
        if constexpr (P + 1 < N_PHASES) xcd_barrier(bar);
        run_all<P + 1>(c, bar);
    }
}
__global__ void __launch_bounds__(512, 2) fwd_kernel(Args args) {
    extern __shared__ __attribute__((aligned(16))) unsigned char lds_raw[];
    Ctx c; make_ctx(c, args, lds_raw);
    LAS unsigned char* lds = c.lds;
    if (threadIdx.x < 4) ((LAS unsigned*)(lds + LDS_MISC))[threadIdx.x] = 0u;
    __syncthreads();
    const XcdBarrier bar = xcd_barrier_post((unsigned*)(args.ws + WS_BAR), (volatile LAS unsigned*)(lds + LDS_MISC));
    run_all<0>(c, bar);
}
#endif

template <int KIND> static void launch_kind(int grid, hipStream_t stream, Args a, int l) {
    static bool set = false;
    if (!set) { (void)hipFuncSetAttribute((const void*)k_phase<KIND>, hipFuncAttributeMaxDynamicSharedMemorySize, LDS_BYTES); set = true; }
    a.ph_lo = l; a.ph_hi = 0;
    hipLaunchKernelGGL(k_phase<KIND>, dim3(grid), dim3(512), LDS_BYTES, stream, a);
}
template <int P> static void launch_all(int grid, hipStream_t stream, const Args& a) {
    if constexpr (P < N_PHASES) { launch_kind<prog_kind(P)>(grid, stream, a, prog_layer(P)); launch_all<P + 1>(grid, stream, a); }
}

extern "C" void kernel_launch(void* const* d_in, const int* in_sizes, int n_in, void* d_out, int out_size, void* d_ws, size_t ws_size, hipStream_t stream) {
    static int grid = 0;
    if (grid == 0) {
        if (n_in != 24 || ws_size < WS_END) { fprintf(stderr, "kernel_launch: unexpected inputs (n_in %d, ws %zu < %zu)\n", n_in, ws_size, (size_t)WS_END); grid = -1; return; }
        int dev = 0, cus = 0, per_cu = 0;
        if (hipGetDevice(&dev) != hipSuccess || hipDeviceGetAttribute(&cus, hipDeviceAttributeMultiprocessorCount, dev) != hipSuccess) { grid = -1; return; }
#if MK_LAUNCHES == 1
        if (hipFuncSetAttribute((const void*)fwd_kernel, hipFuncAttributeMaxDynamicSharedMemorySize, LDS_BYTES) != hipSuccess) { fprintf(stderr, "kernel_launch: hipFuncSetAttribute failed\n"); grid = -1; return; }
        if (hipOccupancyMaxActiveBlocksPerMultiprocessor(&per_cu, (const void*)fwd_kernel, 512, LDS_BYTES) != hipSuccess || per_cu < 1) { fprintf(stderr, "kernel_launch: occupancy query says %d\n", per_cu); (void)hipGetLastError(); }
#endif
        (void)per_cu;
        grid = cus;
    }
    if (grid < 0) return;
    (void)hipMemsetAsync(d_ws, 0, WS_SS, stream);
    Args a{};
    for (int i = 0; i < 24; ++i) a.in[i] = d_in[i];
    a.out = (float*)d_out; a.ws = (unsigned char*)d_ws;
#if MK_LAUNCHES == 1
    a.ph_lo = 0; a.ph_hi = N_PHASES;
    hipLaunchKernelGGL(fwd_kernel, dim3(grid), dim3(512), LDS_BYTES, stream, a);
#else
    launch_all<0>(grid, stream, a);
#endif
}
```

```cpp
#include <hip/hip_runtime.h>
#include <cstdio>
#include <cstdint>

#ifndef MK_LAUNCHES
#define MK_LAUNCHES 1
#endif

#define LAS __attribute__((address_space(3)))
typedef unsigned short bf16_t;
typedef short bf16x8 __attribute__((ext_vector_type(8)));
typedef short s16x4 __attribute__((ext_vector_type(4)));
typedef float f32x2 __attribute__((ext_vector_type(2)));
typedef float f32x4 __attribute__((ext_vector_type(4)));
typedef float f32x16 __attribute__((ext_vector_type(16)));
typedef unsigned u32x2 __attribute__((ext_vector_type(2)));
typedef unsigned u32x4 __attribute__((ext_vector_type(4)));

constexpr int D = 1024, MP = 16384, MS = 128, MT = MP + MS, NPAN = 65, MPAD = NPAN * 256;
constexpr int SEQ = 2048, DSGU = 2048, DFF = 2816, QLR = 384, NH = 16, KVC = 256, RD = 64, QKD = 320, NQ = NH * QKD;
constexpr int NPAGES = 64;
constexpr float EPS = 1e-6f;
constexpr float QSCALE = 0.10411754627697264f;
constexpr int LDS_BYTES = 153600;
constexpr int LDS_MISC = 152576;

constexpr size_t O_YP = 0, O_YS = 16777216, O_KLP = 16908288, O_KRP = 21102592, O_KLS = 22151168, O_KRS = 22183936, O_SGV = 22192128;

constexpr size_t al(size_t x) { return (x + 255) & ~size_t(255); }
constexpr int NSS = 14;
constexpr size_t WS_BAR = 0;
constexpr size_t WS_CNT = al(WS_BAR + 3456 * 4);
constexpr size_t WS_SS = al(WS_CNT + 2 * 128 * 4);
constexpr size_t WS_ZERO_END = al(WS_SS + (size_t)NSS * MPAD * 4);
constexpr size_t WS_ROPE = WS_ZERO_END;
constexpr size_t WS_W1 = al(WS_ROPE + 2049 * 32 * 8);
constexpr size_t WS_W3 = al(WS_W1 + (size_t)2 * 4096 * 1024 * 2);
constexpr size_t WS_W4 = al(WS_W3 + (size_t)2 * 1024 * 2048 * 2);
constexpr size_t WS_W5 = al(WS_W4 + (size_t)4 * 5632 * 1024 * 2);
constexpr size_t WS_WKVQ = al(WS_W5 + (size_t)4 * 1024 * 2816 * 2);
constexpr size_t WS_WDQ1 = al(WS_WKVQ + (size_t)768 * 1024 * 2);
constexpr size_t WS_WQ = al(WS_WDQ1 + (size_t)512 * 1024 * 2);
constexpr size_t WS_WUV = al(WS_WQ + (size_t)2 * 5120 * 384 * 2);
constexpr size_t WS_WO = al(WS_WUV + (size_t)2048 * 512 * 2);
constexpr size_t WS_UKP = al(WS_WO + (size_t)2 * 1024 * 2048 * 2);
constexpr size_t WS_UQP = al(WS_UKP + (size_t)16 * 256 * 256 * 2);
constexpr size_t WS_H = al(WS_UQP + (size_t)2 * 16 * 512 * 256 * 2);
constexpr size_t WS_HB = al(WS_H + (size_t)MPAD * 1024 * 4);
constexpr size_t WS_U = al(WS_HB + (size_t)MPAD * 1024 * 2);
constexpr size_t WS_V = al(WS_U + (size_t)MPAD * 2048 * 2);
constexpr size_t WS_F = al(WS_V + (size_t)MPAD * 2048 * 2);
constexpr size_t WS_CQ = al(WS_F + (size_t)MPAD * 2816 * 2);
constexpr size_t WS_QF = al(WS_CQ + (size_t)MPAD * 384 * 2);
constexpr size_t WS_KVR = al(WS_QF + (size_t)MPAD * 5120 * 2);
constexpr size_t WS_KVB = al(WS_KVR + (size_t)MPAD * 320 * 4);
constexpr size_t WS_OL = al(WS_KVB + (size_t)MPAD * 320 * 2);
constexpr size_t WS_OV = al(WS_OL + (size_t)MPAD * 4096 * 2);
constexpr size_t WS_PO = al(WS_OV + (size_t)MPAD * 2048 * 2);
constexpr size_t WS_PML = al(WS_PO + (size_t)256 * 16 * 256 * 4);
constexpr size_t WS_SLAB = al(WS_PML + 256 * 16 * 8);
constexpr size_t WS_SSP = al(WS_SLAB + (size_t)11 * MS * D * 4);
constexpr size_t WS_SLAB2 = al(WS_SSP + (size_t)MPAD * 32 * 4);
constexpr size_t WS_KC = al(WS_SLAB2 + (size_t)4 * MS * 4096 * 4);
constexpr size_t WS_QH = al(WS_KC + (size_t)256 * 8 * 32 * 10 * 1024);
constexpr size_t WS_KN = al(WS_QH + (size_t)MP * 3072 * 2);
constexpr size_t WS_VH = al(WS_KN + (size_t)MP * 2048 * 2);
constexpr size_t WS_WQS = al(WS_VH + (size_t)MP * 2048 * 2);
constexpr size_t WS_WKV2 = al(WS_WQS + (size_t)2 * 3072 * 384 * 2);
constexpr size_t WS_END = al(WS_WKV2 + (size_t)4096 * 256 * 2);

__device__ __forceinline__ unsigned cvt_pk_bf16(float lo, float hi) { unsigned r; asm volatile("v_cvt_pk_bf16_f32 %0, %1, %2" : "=v"(r) : "v"(lo), "v"(hi)); return r; }
__device__ __forceinline__ float bf_lo(unsigned w) { return __uint_as_float(w << 16); }
__device__ __forceinline__ float bf_hi(unsigned w) { return __uint_as_float(w & 0xffff0000u); }
__device__ __forceinline__ float fast_exp2(float x) { return __builtin_amdgcn_exp2f(x); }
__device__ __forceinline__ float fast_rcp(float x) { return __builtin_amdgcn_rcpf(x); }
__device__ __forceinline__ float gelu_tanh(float x) {
    const float t = x * (1.0f + 0.044715f * x * x);
    return x * fast_rcp(1.0f + fast_exp2(-2.302208198144325f * t));
}
__device__ __forceinline__ float silu_f(float x) { return x * fast_rcp(1.0f + fast_exp2(-1.4426950408889634f * x)); }
__device__ __forceinline__ void atomic_add_f32(float* p, float v) { unsafeAtomicAdd(p, v); }
__device__ __forceinline__ int opaque_tid(int wv) { unsigned z = 0u; asm volatile("" : "+v"(z)); int t = (wv << 6) + (int)__builtin_amdgcn_mbcnt_hi(~0u, __builtin_amdgcn_mbcnt_lo(~0u, z)); asm volatile("" : "+v"(t)); return t; }

#define XB_TMO      128
#define XB_XCNT(j)  (256  + 64 * (j))
#define XB_XSUB(j)  (1280 + 64 * (j))
#define XB_XGEN(j)  (2304 + 64 * (j))
#define XB_TOP      3328
#define XB_TOPGEN   3392
#define XCD_BAR_WORDS 3456
#define XB_SPIN_CAP (1u << 18)

__device__ __forceinline__ unsigned xb_ld(unsigned* p)              { return __hip_atomic_load(p, __ATOMIC_RELAXED, __HIP_MEMORY_SCOPE_AGENT); }
__device__ __forceinline__ unsigned xb_add(unsigned* p, unsigned v) { return __hip_atomic_fetch_add(p, v, __ATOMIC_RELAXED, __HIP_MEMORY_SCOPE_AGENT); }
__device__ __forceinline__ unsigned xb_xcc_id() { return (unsigned)__builtin_amdgcn_s_getreg((3 << 11) | 20) & 0xFu; }
#define XB_SPIN(cond, bar) do { unsigned _sp = 0; while (cond) { __builtin_amdgcn_s_sleep(1); \
    if ((++_sp & 255u) == 0u) { if (xb_ld(&(bar)[XB_TMO])) break; if (_sp > XB_SPIN_CAP) { atomicAdd(&(bar)[XB_TMO], 1u); break; } } } } while (0)

struct XcdBarrier { unsigned* bar; unsigned x; volatile LAS unsigned* st; };

__device__ __forceinline__ XcdBarrier xcd_barrier_post(unsigned* bar, volatile LAS unsigned* st) {
    XcdBarrier b; b.bar = bar; b.x = xb_xcc_id(); b.st = st;
    if (threadIdx.x == 0) (void)xb_add(&bar[XB_XCNT(b.x)], 1u);
    return b;
}
__device__ __forceinline__ void xcd_barrier_complete(unsigned* bar, unsigned x, unsigned& nloc, unsigned& nx) {
    const unsigned G = gridDim.x * gridDim.y * gridDim.z;
    unsigned sum, cnt, mine, sp = 0u;
    for (;;) {
        sum = 0u; cnt = 0u; mine = 0u;
#pragma unroll
        for (unsigned j = 0; j < 16; ++j) { const unsigned c = xb_ld(&bar[XB_XCNT(j)]); sum += c; cnt += (c > 0u) ? 1u : 0u; mine = (j == x) ? c : mine; }
        if (sum == G) break;
        __builtin_amdgcn_s_sleep(1);
        if ((++sp & 255u) == 0u) { if (xb_ld(&bar[XB_TMO])) break; if (sp > XB_SPIN_CAP) { atomicAdd(&bar[XB_TMO], 1u); break; } }
    }
    nloc = mine > 0u ? mine : 1u; nx = cnt > 0u ? cnt : 1u;
}
__device__ __forceinline__ void xcd_barrier(const XcdBarrier& b) {
    asm volatile("s_waitcnt vmcnt(0)" ::: "memory");
    __syncthreads();
    if (threadIdx.x == 0) {
        unsigned* bar = b.bar;
        __builtin_amdgcn_s_waitcnt(0);
        unsigned nloc = b.st[0], nx = b.st[1];
        if (nloc == 0u) { xcd_barrier_complete(bar, b.x, nloc, nx); b.st[0] = nloc; b.st[1] = nx; }
        const unsigned old = xb_add(&bar[XB_XSUB(b.x)], 1u);
        const unsigned gen = old / nloc;
        if (old + 1u == (gen + 1u) * nloc) {
            __builtin_amdgcn_fence(__ATOMIC_RELEASE, "agent");
            asm volatile("s_waitcnt vmcnt(0)" ::: "memory");
            const unsigned og = xb_add(&bar[XB_TOP], 1u);
            const unsigned tg = og / nx;
            if (og + 1u == (tg + 1u) * nx) xb_add(&bar[XB_TOPGEN], 1u);
            else XB_SPIN(xb_ld(&bar[XB_TOPGEN]) == tg, bar);
            __builtin_amdgcn_fence(__ATOMIC_ACQUIRE, "agent");
            xb_add(&bar[XB_XGEN(b.x)], 1u);
            asm volatile("s_waitcnt vmcnt(0)" ::: "memory");
        } else {
            XB_SPIN(xb_ld(&bar[XB_XGEN(b.x)]) == gen, bar);
            __builtin_amdgcn_fence(__ATOMIC_ACQUIRE, "agent");
            asm volatile("s_waitcnt vmcnt(0)" ::: "memory");
        }
    }
    __syncthreads();
}

namespace pg8 {
constexpr int BM = 256, BK = 64, HALF = 128, HTB = HALF * BK * 2, STAGE_BYTES = 8 * HTB, NXCD = 8, WGM = 4, NPAN_ = 65;
__host__ __device__ __forceinline__ int lds_byte(int r, int c) { const int st = (r >> 4) * 2 + (c >> 5), rr = r & 15, cc = c & 31, ob = rr * 64 + cc * 2; return st * 1024 + (ob ^ (((ob >> 9) & 1) << 5)); }
__host__ __device__ __forceinline__ void stage_rc(int b, int& R, int& C) { const int st = b / 1024, sb = b % 1024, swz = sb ^ (((sb >> 9) & 1) << 5); R = (st >> 1) * 16 + swz / 64; C = (st & 1) * 32 + (swz % 64) / 2; }
__host__ __device__ __forceinline__ int perm32(int rho) { const int n = rho >> 4, i = rho & 15; return 8 * (i >> 2) + 4 * n + (i & 3); }

struct Unit { int pm, pn, kc; };
struct Gemm { const bf16_t* A; const bf16_t* Bt; int lda, ldb, K; };

struct OrderMN {
    int nM, nN, nwg, G, c;
    __device__ void init(int nM_, int nN_, int G_, int c_) { nM = nM_; nN = nN_; nwg = nM * nN; G = G_; c = c_; }
    __device__ bool next(int i, Unit& u) const {
        const long L = (long)i * G + c; if (L >= nwg) return false;
        int wgid = (int)L; { const int q = nwg / NXCD, r = nwg % NXCD, xcd = wgid % NXCD, off = wgid / NXCD; wgid = (xcd < r ? xcd * (q + 1) : r * (q + 1) + (xcd - r) * q) + off; }
        const int nig = WGM * nN, gid = wgid / nig, fm = gid * WGM, gsz = (nM - fm) < WGM ? (nM - fm) : WGM;
        u.pm = fm + ((wgid % nig) % gsz); u.pn = (wgid % nig) / gsz; u.kc = 0; return true;
    }
    __device__ __forceinline__ int ktiles(const Gemm& g, const Unit&) const { return g.K / BK; }
    __device__ __forceinline__ const char* aptr(const Gemm& g, const Unit& u) const { return (const char*)(g.A + (size_t)u.pm * BM * g.lda); }
    __device__ __forceinline__ const char* bptr(const Gemm& g, const Unit& u) const { return (const char*)(g.Bt + (size_t)u.pn * BM * g.ldb); }
};

template <class Epi, class Sched>
__device__ __forceinline__ void gemm_phase(LAS unsigned char* lds, const Gemm g, const Sched& S, const Epi& E, int wv) {
    const int tid = opaque_tid(wv), wid = __builtin_amdgcn_readfirstlane(tid >> 6), lane = tid & 63, wr = wid >> 2, wc = wid & 3, fr = lane & 15, fq = lane >> 4;
    unsigned voffA[2], voffB[2];
#pragma unroll
    for (int i = 0; i < 2; ++i) { int R, C; stage_rc(tid * 16 + i * 8192, R, C); const int Rb = Epi::PERM ? ((R & ~31) + perm32(R & 31)) : R;
        voffA[i] = (unsigned)(R * g.lda + C) * 2u; voffB[i] = (unsigned)(Rb * g.ldb + C) * 2u; }
    const size_t kstep = (size_t)(BK * 2);
    const size_t hsA = (size_t)HALF * g.lda * 2, hsB = (size_t)HALF * g.ldb * 2;
    const unsigned ldsw = (unsigned)wid * 1024u;
    const int aoff = lds_byte(wr * 64 + fr, fq * 8), boff = lds_byte(wc * 32 + fr, fq * 8);
#define PG8_SA(b, h) (((b) * 2 + (h)) * HTB)
#define PG8_SB(b, h) ((4 + (b) * 2 + (h)) * HTB)
#define PG8_STAGE(bufoff, gbase, voff) do { _Pragma("unroll") for (int _i = 0; _i < 2; ++_i) \
        __builtin_amdgcn_global_load_lds((const unsigned*)((const char*)(gbase) + (voff)[_i]), (LAS unsigned*)(lds + (bufoff) + ldsw + _i * 8192), 16, 0, 0); } while (0)
#define PG8_LDA(dst, b, h) do { _Pragma("unroll") for (int m = 0; m < 4; ++m) _Pragma("unroll") for (int k = 0; k < 2; ++k) dst[m][k] = *(const LAS bf16x8*)(lds + PG8_SA(b, h) + aoff + m * 2048 + k * 1024); } while (0)
#define PG8_LDB(dst, b, h) do { _Pragma("unroll") for (int n = 0; n < 2; ++n) _Pragma("unroll") for (int k = 0; k < 2; ++k) dst[n][k] = *(const LAS bf16x8*)(lds + PG8_SB(b, h) + boff + n * 2048 + k * 1024); } while (0)
#define PG8_MMA(ai, bj, At, Bt) do { __builtin_amdgcn_s_setprio(1); _Pragma("unroll") for (int m = 0; m < 4; ++m) _Pragma("unroll") for (int n = 0; n < 2; ++n) _Pragma("unroll") for (int k = 0; k < 2; ++k) \
        acc[ai][bj][m][n] = __builtin_amdgcn_mfma_f32_16x16x32_bf16(Bt[n][k], At[m][k], acc[ai][bj][m][n], 0, 0, 0); __builtin_amdgcn_s_setprio(0); } while (0)
#define PG8_WAIT_V(n) asm volatile("s_waitcnt vmcnt(" #n ")" ::: "memory")
#define PG8_WAIT_L(n) asm volatile("s_waitcnt lgkmcnt(" #n ")" ::: "memory")
#define PG8_BAR __builtin_amdgcn_s_barrier()
#define PG8_SCHED __builtin_amdgcn_sched_barrier(0)
    Unit cur, nxt; int ui = 0;
    if (!S.next(0, cur)) return;
    int nt = S.ktiles(g, cur); asm volatile("" : "+s"(nt));
    bool half = cur.pm == NPAN_ - 1;
    f32x4 acc[2][2][4][2];
#pragma unroll
    for (int a = 0; a < 2; ++a)
#pragma unroll
        for (int b = 0; b < 2; ++b)
#pragma unroll
            for (int m = 0; m < 4; ++m)
#pragma unroll
                for (int n = 0; n < 2; ++n) acc[a][b][m][n] = (f32x4){0.f, 0.f, 0.f, 0.f};
    bf16x8 At[4][2], B0[2][2], B1[2][2];
    const char* cA = S.aptr(g, cur); const char* cB = S.bptr(g, cur);
    typename Epi::Pre pre = E.pre(cur, wr, wc, fr, fq);
    PG8_STAGE(PG8_SB(0, 0), cB, voffB); PG8_STAGE(PG8_SA(0, 0), cA, voffA); PG8_STAGE(PG8_SB(0, 1), cB + hsB, voffB); PG8_STAGE(PG8_SA(0, 1), cA + hsA, voffA);
    if (wr == 1) PG8_BAR;
    PG8_WAIT_V(4); PG8_BAR;
    PG8_STAGE(PG8_SB(1, 0), cB + kstep, voffB); PG8_STAGE(PG8_SA(1, 0), cA + kstep, voffA); PG8_STAGE(PG8_SB(1, 1), cB + hsB + kstep, voffB);
    PG8_WAIT_V(6); PG8_BAR;
    for (;;) {
        const bool has_next = S.next(ui + 1, nxt);
        const char* nA = has_next ? S.aptr(g, nxt) : cA; const char* nB = has_next ? S.bptr(g, nxt) : cB;
        for (int t = 0; t < nt; t += 2) {
            const bool last = (t == nt - 2);
            const char* a1 = cA + (size_t)(t + 1) * kstep;
            const char* a2 = last ? nA : cA + (size_t)(t + 2) * kstep; const char* b2 = last ? nB : cB + (size_t)(t + 2) * kstep;
            const char* a3 = a2 + kstep; const char* b3 = b2 + kstep;
            PG8_LDB(B0, 0, 0); PG8_SCHED; PG8_LDA(At, 0, 0); PG8_STAGE(PG8_SA(1, 1), a1 + hsA, voffA);
            PG8_WAIT_L(8); PG8_BAR; PG8_WAIT_L(0); PG8_MMA(0, 0, At, B0); PG8_BAR; PG8_SCHED;
            PG8_LDB(B1, 0, 1); PG8_STAGE(PG8_SB(0, 0), b2, voffB);
            PG8_BAR; PG8_WAIT_L(0); PG8_MMA(0, 1, At, B1); PG8_BAR;
            PG8_LDA(At, 0, 1); PG8_STAGE(PG8_SA(0, 0), a2, voffA);
            PG8_BAR; PG8_WAIT_L(0); if (!half) PG8_MMA(1, 0, At, B0); PG8_BAR; PG8_SCHED;
            PG8_STAGE(PG8_SB(0, 1), b2 + hsB, voffB);
            PG8_WAIT_V(6); PG8_BAR; if (!half) PG8_MMA(1, 1, At, B1); PG8_BAR;
            PG8_LDB(B0, 1, 0); PG8_SCHED; PG8_LDA(At, 1, 0); PG8_STAGE(PG8_SA(0, 1), a2 + hsA, voffA);
            PG8_WAIT_L(8); PG8_BAR; PG8_WAIT_L(0); PG8_MMA(0, 0, At, B0); PG8_BAR; PG8_SCHED;
            PG8_LDB(B1, 1, 1); PG8_STAGE(PG8_SB(1, 0), b3, voffB);
            PG8_BAR; PG8_WAIT_L(0); PG8_MMA(0, 1, At, B1); PG8_BAR;
            PG8_LDA(At, 1, 1); PG8_STAGE(PG8_SA(1, 0), a3, voffA);
            PG8_BAR; PG8_WAIT_L(0); if (!half) PG8_MMA(1, 0, At, B0); PG8_BAR; PG8_SCHED;
            PG8_STAGE(PG8_SB(1, 1), b3 + hsB, voffB);
            PG8_WAIT_V(6); PG8_BAR; if (!half) PG8_MMA(1, 1, At, B1); PG8_BAR;
        }
        E(acc, cur, wr, wc, fr, fq, pre);
        if (!has_next) break;
        pre = E.pre(nxt, wr, wc, fr, fq);
#pragma unroll
        for (int a = 0; a < 2; ++a)
#pragma unroll
            for (int b = 0; b < 2; ++b)
#pragma unroll
                for (int m = 0; m < 4; ++m)
#pragma unroll
                    for (int n = 0; n < 2; ++n) acc[a][b][m][n] = (f32x4){0.f, 0.f, 0.f, 0.f};
        cur = nxt; cA = nA; cB = nB; ++ui; nt = S.ktiles(g, cur); half = cur.pm == NPAN_ - 1;
    }
    PG8_WAIT_V(0);
    if (wr == 0) PG8_BAR;
    PG8_BAR;
#undef PG8_SA
#undef PG8_SB
#undef PG8_STAGE
#undef PG8_LDA
#undef PG8_LDB
#undef PG8_MMA
#undef PG8_WAIT_V
#undef PG8_WAIT_L
#undef PG8_BAR
#undef PG8_SCHED
}
}

typedef f32x4 AccT[2][2][4][2];
__device__ __forceinline__ float shfl_xor_l(float v, int o, int lane) { return __builtin_bit_cast(float, __builtin_amdgcn_ds_bpermute((lane ^ o) << 2, __builtin_bit_cast(int, v))); }
__device__ __forceinline__ float rsum4(const f32x4 v) { return (v[0] * v[0] + v[1] * v[1]) + (v[2] * v[2] + v[3] * v[3]); }
__device__ __forceinline__ float red_fq(float s, int lane) { s += shfl_xor_l(s, 16, lane); s += shfl_xor_l(s, 32, lane); return s; }
#define PH_IDS const int tid_ = opaque_tid(c.wv), lane_ = tid_ & 63, wave_ = __builtin_amdgcn_readfirstlane(tid_ >> 6); (void)lane_; (void)wave_
#define ROW_OK(u, ai) (!((u).pm == NPAN - 1 && (ai) == 1))

struct EpiSgu {
    static constexpr bool PERM = true;
    const float* ss; bf16_t* U; bf16_t* V; float* vss; float* slab;
    struct Pre { float rs[2][4]; };
    __device__ __forceinline__ Pre pre(const pg8::Unit& u, int wr, int wc, int fr, int fq) const { Pre p; const int row0 = u.pm * 256 + wr * 64 + fr;
#pragma unroll
        for (int ai = 0; ai < 2; ++ai)
#pragma unroll
            for (int m = 0; m < 4; ++m) p.rs[ai][m] = ROW_OK(u, ai) ? ss[row0 + ai * 128 + m * 16] : 1.f;
        return p; }
    __device__ __forceinline__ void operator()(const AccT& acc, const pg8::Unit& u, int wr, int wc, int fr, int fq, const Pre& pre) const {
        const int row0 = u.pm * 256 + wr * 64 + fr; const int colt = u.pn * 256; const bool isV = colt >= DSGU;
        if (u.pm == NPAN - 1) {
#pragma unroll
            for (int m = 0; m < 4; ++m) { float* sp = slab + ((size_t)u.kc * MS + (wr * 64 + m * 16 + fr)) * 4096 + colt + wc * 32 + 8 * fq;
#pragma unroll
                for (int bj = 0; bj < 2; ++bj) { *(f32x4*)(sp + bj * 128) = acc[0][bj][m][0]; *(f32x4*)(sp + bj * 128 + 4) = acc[0][bj][m][1]; } }
            return;
        }
        bf16_t* base = isV ? V : U; const int cb = (isV ? colt - DSGU : colt) + wc * 32 + 8 * fq;
#pragma unroll
        for (int ai = 0; ai < 2; ++ai) { if (!ROW_OK(u, ai)) continue;
#pragma unroll
            for (int m = 0; m < 4; ++m) { const int row = row0 + ai * 128 + m * 16; const float rstd = rsqrtf(pre.rs[ai][m] * (1.0f / D) + EPS); float sq = 0.f;
#pragma unroll
                for (int bj = 0; bj < 2; ++bj) { f32x4 v0 = acc[ai][bj][m][0] * rstd, v1 = acc[ai][bj][m][1] * rstd;
#pragma unroll
                    for (int j = 0; j < 4; ++j) { v0[j] = gelu_tanh(v0[j]); v1[j] = gelu_tanh(v1[j]); }
                    sq += rsum4(v0) + rsum4(v1);
                    u32x4 w; w.x = cvt_pk_bf16(v0[0], v0[1]); w.y = cvt_pk_bf16(v0[2], v0[3]); w.z = cvt_pk_bf16(v1[0], v1[1]); w.w = cvt_pk_bf16(v1[2], v1[3]);
                    *(u32x4*)(base + (size_t)row * DSGU + cb + bj * 128) = w; }
                if (isV) { sq = red_fq(sq, fr + 16 * fq); if (fq == 0) vss[(size_t)row * 32 + (u.pn - 8) * 4 + wc] = sq; } } }
    }
};
struct EpiRes {
    static constexpr bool PERM = true;
    bf16_t* Hb; float* ssout; float* slab; bf16_t* Hd;
    struct Pre {};
    __device__ __forceinline__ Pre pre(const pg8::Unit&, int, int, int, int) const { return Pre{}; }
    __device__ __forceinline__ void operator()(const AccT& acc, const pg8::Unit& u, int wr, int wc, int fr, int fq, const Pre& pre) const {
        const int row0 = u.pm * 256 + wr * 64 + fr; const int col0 = u.pn * 256 + wc * 32 + 8 * fq;
        if (u.pm == NPAN - 1) {
#pragma unroll
            for (int m = 0; m < 4; ++m) { float* sp = slab + ((size_t)u.kc * MS + (wr * 64 + m * 16 + fr)) * D + col0;
#pragma unroll
                for (int bj = 0; bj < 2; ++bj) { *(f32x4*)(sp + bj * 128) = acc[0][bj][m][0]; *(f32x4*)(sp + bj * 128 + 4) = acc[0][bj][m][1]; } }
            return;
        }
#pragma unroll
        for (int ai = 0; ai < 2; ++ai) {
            u32x4 ball[4][2];
#pragma unroll
            for (int m = 0; m < 4; ++m)
#pragma unroll
                for (int bj = 0; bj < 2; ++bj) ball[m][bj] = *(const u32x4*)(Hb + (size_t)(row0 + ai * 128 + m * 16) * D + col0 + bj * 128);
#pragma unroll
            for (int m = 0; m < 4; ++m) { const int row = row0 + ai * 128 + m * 16; bf16_t* hp = Hb + (size_t)row * D + col0; float sq = 0.f;
                u32x4 b[2] = {ball[m][0], ball[m][1]};
#pragma unroll
                for (int bj = 0; bj < 2; ++bj) { const f32x4 a0 = acc[ai][bj][m][0], a1 = acc[ai][bj][m][1]; float o[8];
                    o[0] = bf_lo(b[bj].x) + a0[0]; o[1] = bf_hi(b[bj].x) + a0[1]; o[2] = bf_lo(b[bj].y) + a0[2]; o[3] = bf_hi(b[bj].y) + a0[3];
                    o[4] = bf_lo(b[bj].z) + a1[0]; o[5] = bf_hi(b[bj].z) + a1[1]; o[6] = bf_lo(b[bj].w) + a1[2]; o[7] = bf_hi(b[bj].w) + a1[3];
#pragma unroll
                    for (int i = 0; i < 8; ++i) sq += o[i] * o[i];
                    u32x4 w; w.x = cvt_pk_bf16(o[0], o[1]); w.y = cvt_pk_bf16(o[2], o[3]); w.z = cvt_pk_bf16(o[4], o[5]); w.w = cvt_pk_bf16(o[6], o[7]);
                    *(u32x4*)(Hd + (size_t)row * D + col0 + bj * 128) = w; }
                sq = red_fq(sq, fr + 16 * fq); if (fq == 0) ssout[(size_t)row * 32 + u.pn * 4 + wc] = sq; } }
    }
};
struct EpiFfn {
    static constexpr bool PERM = true;
    const float* ss; bf16_t* F;
    struct Pre { float rs[2][4]; };
    __device__ __forceinline__ Pre pre(const pg8::Unit& u, int wr, int wc, int fr, int fq) const { Pre p; const int row0 = u.pm * 256 + wr * 64 + fr;
#pragma unroll
        for (int ai = 0; ai < 2; ++ai)
#pragma unroll
            for (int m = 0; m < 4; ++m) p.rs[ai][m] = ROW_OK(u, ai) ? ss[row0 + ai * 128 + m * 16] : 1.f;
        return p; }
    __device__ __forceinline__ void operator()(const AccT& acc, const pg8::Unit& u, int wr, int wc, int fr, int fq, const Pre& pre) const {
        const int row0 = u.pm * 256 + wr * 64 + fr; const int col = u.pn * 128 + wc * 32 + 8 * fq;
#pragma unroll
        for (int ai = 0; ai < 2; ++ai) { if (!ROW_OK(u, ai)) continue;
#pragma unroll
            for (int m = 0; m < 4; ++m) { const int row = row0 + ai * 128 + m * 16; const float rstd = rsqrtf(pre.rs[ai][m] * (1.0f / D) + EPS);
                float f[8];
#pragma unroll
                for (int n = 0; n < 2; ++n)
#pragma unroll
                    for (int j = 0; j < 4; ++j) f[n * 4 + j] = silu_f(acc[ai][0][m][n][j] * rstd) * (acc[ai][1][m][n][j] * rstd);
                u32x4 w; w.x = cvt_pk_bf16(f[0], f[1]); w.y = cvt_pk_bf16(f[2], f[3]); w.z = cvt_pk_bf16(f[4], f[5]); w.w = cvt_pk_bf16(f[6], f[7]);
                *(u32x4*)(F + (size_t)row * DFF + col) = w; } }
    }
};
struct EpiKvq {
    static constexpr bool PERM = true;
    const float* ss; float* KVR; float* ssp; bf16_t* CQ; int c_end, kv_end, cq_end;
    struct Pre { float rs[2][4]; };
    __device__ __forceinline__ Pre pre(const pg8::Unit& u, int wr, int wc, int fr, int fq) const { Pre p; const int row0 = u.pm * 256 + wr * 64 + fr;
#pragma unroll
        for (int ai = 0; ai < 2; ++ai)
#pragma unroll
            for (int m = 0; m < 4; ++m) p.rs[ai][m] = ROW_OK(u, ai) ? ss[row0 + ai * 128 + m * 16] : 1.f;
        return p; }
    __device__ __forceinline__ void operator()(const AccT& acc, const pg8::Unit& u, int wr, int wc, int fr, int fq, const Pre& pre) const {
        const int row0 = u.pm * 256 + wr * 64 + fr; const int colt = u.pn * 256;
        const bool hasC = colt < c_end, hasQ = (colt + 256 > kv_end) && (colt < cq_end);
#pragma unroll
        for (int ai = 0; ai < 2; ++ai) { if (!ROW_OK(u, ai)) continue;
#pragma unroll
            for (int m = 0; m < 4; ++m) { const int row = row0 + ai * 128 + m * 16; const float rstd = rsqrtf(pre.rs[ai][m] * (1.0f / D) + EPS); float sqc = 0.f, sqq = 0.f;
#pragma unroll
                for (int bj = 0; bj < 2; ++bj) { const int col = colt + bj * 128 + wc * 32 + 8 * fq; const f32x4 v0 = acc[ai][bj][m][0] * rstd, v1 = acc[ai][bj][m][1] * rstd;
                    if (col < kv_end) { *(f32x4*)(KVR + (size_t)row * QKD + col) = v0; *(f32x4*)(KVR + (size_t)row * QKD + col + 4) = v1; if (col < c_end) sqc += rsum4(v0) + rsum4(v1); }
                    else if (col < cq_end) { sqq += rsum4(v0) + rsum4(v1);
                        u32x4 w; w.x = cvt_pk_bf16(v0[0], v0[1]); w.y = cvt_pk_bf16(v0[2], v0[3]); w.z = cvt_pk_bf16(v1[0], v1[1]); w.w = cvt_pk_bf16(v1[2], v1[3]);
                        *(u32x4*)(CQ + (size_t)row * QLR + (col - kv_end)) = w; } }
                if (hasC) { sqc = red_fq(sqc, fr + 16 * fq); if (fq == 0) ssp[(size_t)row * 32 + wc] = sqc; }
                if (hasQ) { sqq = red_fq(sqq, fr + 16 * fq); if (fq == 0) ssp[(size_t)row * 32 + 8 + 4 * (u.pn - (kv_end ? 1 : 0)) + wc] = sqq; } } }
    }
};
struct EpiQ {
    static constexpr bool PERM = true;
    const float* ssp; bf16_t* QF; const f32x2* rope; bf16_t* QH;
    struct Pre {};
    __device__ __forceinline__ Pre pre(const pg8::Unit&, int, int, int, int) const { return Pre{}; }
    __device__ __forceinline__ void operator()(const AccT& acc, const pg8::Unit& u, int wr, int wc, int fr, int fq, const Pre& pre) const {
        const int row0 = u.pm * 256 + wr * 64 + fr; const int colt = u.pn * 256; const bool sample = u.pm == NPAN - 1;
        float rs[2][4];
#pragma unroll
        for (int ai = 0; ai < 2; ++ai)
#pragma unroll
            for (int m = 0; m < 4; ++m) { rs[ai][m] = 1.f; if (ROW_OK(u, ai)) { const float* pp = ssp + (size_t)(row0 + ai * 128 + m * 16) * 32 + 8; const f32x4 pa = *(const f32x4*)pp, pb = *(const f32x4*)(pp + 4);
                rs[ai][m] = ((pa[0] + pa[1]) + (pa[2] + pa[3])) + ((pb[0] + pb[1]) + (pb[2] + pb[3])); } }
#pragma unroll
        for (int ai = 0; ai < 2; ++ai) { if (!ROW_OK(u, ai)) continue;
#pragma unroll
            for (int m = 0; m < 4; ++m) { const int row = row0 + ai * 128 + m * 16;
                const float rstd = rsqrtf(rs[ai][m] * (1.0f / QLR) + EPS) * QSCALE;
                const int pidx = sample ? SEQ : (row & (SEQ - 1));
#pragma unroll
                for (int bj = 0; bj < 2; ++bj) { const int col = colt + bj * 128 + wc * 32 + 8 * fq;
                    if (!sample) {
                        const int hh = col / 192, c2 = col - hh * 192; float q[8];
#pragma unroll
                        for (int jj = 0; jj < 4; ++jj) { q[jj] = acc[ai][bj][m][0][jj] * rstd; q[4 + jj] = acc[ai][bj][m][1][jj] * rstd; }
                        if (c2 >= 128) { const int i0 = (c2 - 128) >> 1;
#pragma unroll
                            for (int pp = 0; pp < 4; ++pp) { const f32x2 cs = rope[pidx * 32 + i0 + pp]; const float x1 = q[2 * pp], x2 = q[2 * pp + 1]; q[2 * pp] = x1 * cs.x - x2 * cs.y; q[2 * pp + 1] = x2 * cs.x + x1 * cs.y; } }
                        u32x4 w; w.x = cvt_pk_bf16(q[0], q[1]); w.y = cvt_pk_bf16(q[2], q[3]); w.z = cvt_pk_bf16(q[4], q[5]); w.w = cvt_pk_bf16(q[6], q[7]);
                        *(u32x4*)(QH + (size_t)row * 3072 + col) = w; continue; }
                    const int head = col / QKD, cc = col - head * QKD;
                    float v[8];
#pragma unroll
                    for (int j = 0; j < 4; ++j) { v[j] = acc[ai][bj][m][0][j] * rstd; v[4 + j] = acc[ai][bj][m][1][j] * rstd; }
                    bf16_t* dst = QF + (size_t)row * NQ + col;
                    if (cc < KVC) { u32x4 w; w.x = cvt_pk_bf16(v[0], v[1]); w.y = cvt_pk_bf16(v[2], v[3]); w.z = cvt_pk_bf16(v[4], v[5]); w.w = cvt_pk_bf16(v[6], v[7]); *(u32x4*)dst = w; }
                    else { const int i0 = (cc - KVC) >> 1; float o1[4], o2[4];
#pragma unroll
                        for (int p = 0; p < 4; ++p) { const f32x2 cs = rope[pidx * 32 + i0 + p]; o1[p] = v[2 * p] * cs.x - v[2 * p + 1] * cs.y; o2[p] = v[2 * p + 1] * cs.x + v[2 * p] * cs.y; }
                        if (!sample) { u32x4 w; w.x = cvt_pk_bf16(o1[0], o2[0]); w.y = cvt_pk_bf16(o1[1], o2[1]); w.z = cvt_pk_bf16(o1[2], o2[2]); w.w = cvt_pk_bf16(o1[3], o2[3]); *(u32x4*)dst = w; }
                        else { bf16_t* hb = QF + (size_t)row * NQ + head * QKD + KVC;
                            u32x2 a, b; a.x = cvt_pk_bf16(o1[0], o1[1]); a.y = cvt_pk_bf16(o1[2], o1[3]); b.x = cvt_pk_bf16(o2[0], o2[1]); b.y = cvt_pk_bf16(o2[2], o2[3]);
                            *(u32x2*)(hb + i0) = a; *(u32x2*)(hb + 32 + i0) = b; } } }
                asm volatile("" ::: "memory"); } }
    }
};
struct EpiPlain {
    static constexpr bool PERM = true;
    bf16_t* O; int ldc;
    struct Pre {};
    __device__ __forceinline__ Pre pre(const pg8::Unit&, int, int, int, int) const { return Pre{}; }
    __device__ __forceinline__ void operator()(const AccT& acc, const pg8::Unit& u, int wr, int wc, int fr, int fq, const Pre& pre) const {
        const int row0 = u.pm * 256 + wr * 64 + fr; const int col0 = u.pn * 256 + wc * 32 + 8 * fq;
#pragma unroll
        for (int ai = 0; ai < 2; ++ai) { if (!ROW_OK(u, ai)) continue;
#pragma unroll
            for (int m = 0; m < 4; ++m) { const int row = row0 + ai * 128 + m * 16;
#pragma unroll
                for (int bj = 0; bj < 2; ++bj) { const f32x4 v0 = acc[ai][bj][m][0], v1 = acc[ai][bj][m][1];
                    u32x4 w; w.x = cvt_pk_bf16(v0[0], v0[1]); w.y = cvt_pk_bf16(v0[2], v0[3]); w.z = cvt_pk_bf16(v1[0], v1[1]); w.w = cvt_pk_bf16(v1[2], v1[3]);
                    *(u32x4*)(O + (size_t)row * ldc + col0 + bj * 128) = w; } } }
    }
};
struct EpiKvup {
    static constexpr bool PERM = true;
    bf16_t* KN; bf16_t* VH;
    struct Pre {};
    __device__ __forceinline__ Pre pre(const pg8::Unit&, int, int, int, int) const { return Pre{}; }
    __device__ __forceinline__ void operator()(const AccT& acc, const pg8::Unit& u, int wr, int wc, int fr, int fq, const Pre&) const {
        const int row0 = u.pm * 256 + wr * 64 + fr;
#pragma unroll
        for (int ai = 0; ai < 2; ++ai)
#pragma unroll
            for (int m = 0; m < 4; ++m) { const int row = row0 + ai * 128 + m * 16; const size_t o = ((size_t)((row >> 11) * NH + u.pn) * SEQ + (row & (SEQ - 1))) * 128 + wc * 32 + 8 * fq;
#pragma unroll
                for (int bj = 0; bj < 2; ++bj) { const f32x4 v0 = acc[ai][bj][m][0], v1 = acc[ai][bj][m][1];
                    u32x4 w; w.x = cvt_pk_bf16(v0[0], v0[1]); w.y = cvt_pk_bf16(v0[2], v0[3]); w.z = cvt_pk_bf16(v1[0], v1[1]); w.w = cvt_pk_bf16(v1[2], v1[3]);
                    *(u32x4*)((bj ? VH : KN) + o) = w; } }
    }
};
struct OrderAbs {
    int G, c;
    __device__ bool next(int i, pg8::Unit& u) const { const int L = i * G + c; if (L >= 64) return false; u.pm = L >> 1; u.pn = L & 1; u.kc = 0; return true; }
    __device__ __forceinline__ int ktiles(const pg8::Gemm& g, const pg8::Unit&) const { return g.K / pg8::BK; }
    __device__ __forceinline__ const char* aptr(const pg8::Gemm& g, const pg8::Unit& u) const { return (const char*)(g.A + (size_t)(u.pm & 15) * 65536); }
    __device__ __forceinline__ const char* bptr(const pg8::Gemm& g, const pg8::Unit& u) const { return (const char*)(g.Bt + ((size_t)u.pm * 512 + u.pn * 256) * 256); }
};
struct EpiAbs {
    static constexpr bool PERM = true;
    bf16_t* WQ;
    struct Pre {};
    __device__ __forceinline__ Pre pre(const pg8::Unit&, int, int, int, int) const { return Pre{}; }
    __device__ __forceinline__ void operator()(const AccT& acc, const pg8::Unit& u, int wr, int wc, int fr, int fq, const Pre& pre) const {
        const int j = u.pm >> 4, h = u.pm & 15; bf16_t* base = WQ + ((size_t)j * NQ + h * QKD) * QLR;
#pragma unroll
        for (int ai = 0; ai < 2; ++ai)
#pragma unroll
            for (int m = 0; m < 4; ++m) { const int c = wr * 64 + ai * 128 + m * 16 + fr;
#pragma unroll
                for (int bj = 0; bj < 2; ++bj) { const int r = u.pn * 256 + bj * 128 + wc * 32 + 8 * fq; const f32x4 v0 = acc[ai][bj][m][0], v1 = acc[ai][bj][m][1];
                    u32x4 w; w.x = cvt_pk_bf16(v0[0], v0[1]); w.y = cvt_pk_bf16(v0[2], v0[3]); w.z = cvt_pk_bf16(v1[0], v1[1]); w.w = cvt_pk_bf16(v1[2], v1[3]);
                    if (r < QLR) *(u32x4*)(base + (size_t)c * QLR + r) = w; }
                asm volatile("" ::: "memory"); }
    }
};
struct OrderRes {
    pg8::OrderMN base; int nN, nkc, nreg;
    __device__ void init(int nN_, int nkc_, int G_, int c_) { base.init(64, nN_, G_, c_); nN = nN_; nkc = nkc_; nreg = 64 * nN_; }
    __device__ bool next(int i, pg8::Unit& u) const { const int L = i * base.G + base.c; if (L < nreg) return base.next(i, u);
        const int idx = L - nreg; if (idx >= nkc * nN) return false; u.pm = NPAN - 1; u.pn = idx % nN; u.kc = idx / nN; return true; }
    __device__ __forceinline__ const char* aptr(const pg8::Gemm& g, const pg8::Unit& u) const { return (const char*)(g.A + (size_t)u.pm * 256 * g.lda + (size_t)u.kc * 256); }
    __device__ __forceinline__ const char* bptr(const pg8::Gemm& g, const pg8::Unit& u) const { return (const char*)(g.Bt + (size_t)u.pn * 256 * g.ldb + (size_t)u.kc * 256); }
    __device__ __forceinline__ int ktiles(const pg8::Gemm& g, const pg8::Unit& u) const { return u.pm == NPAN - 1 ? 4 : g.K / pg8::BK; }
};
struct OrderQ2 {
    pg8::OrderMN base; const bf16_t* babs;
    __device__ void init(const bf16_t* babs_, int G_, int c_) { base.init(64, 12, G_, c_); babs = babs_; }
    __device__ bool next(int i, pg8::Unit& u) const { const int L = i * base.G + base.c; if (L < 768) return base.next(i, u);
        const int idx = L - 768; if (idx >= 20) return false; u.pm = NPAN - 1; u.pn = idx; u.kc = 0; return true; }
    __device__ __forceinline__ const char* aptr(const pg8::Gemm& g, const pg8::Unit& u) const { return (const char*)(g.A + (size_t)u.pm * 256 * g.lda); }
    __device__ __forceinline__ const char* bptr(const pg8::Gemm& g, const pg8::Unit& u) const { return (const char*)((u.pm == NPAN - 1 ? babs : g.Bt) + (size_t)u.pn * 256 * g.ldb); }
    __device__ __forceinline__ int ktiles(const pg8::Gemm& g, const pg8::Unit&) const { return g.K / pg8::BK; }
};
struct OrderUvS {
    int G, c;
    __device__ bool next(int i, pg8::Unit& u) const { const int L = i * G + c; if (L >= 8) return false; u.pm = NPAN - 1; u.pn = L; u.kc = 0; return true; }
    __device__ __forceinline__ const char* aptr(const pg8::Gemm& g, const pg8::Unit& u) const { return (const char*)(g.A + (size_t)u.pm * 256 * g.lda + (size_t)u.pn * 512); }
    __device__ __forceinline__ const char* bptr(const pg8::Gemm& g, const pg8::Unit& u) const { return (const char*)(g.Bt + (size_t)u.pn * 256 * g.ldb); }
    __device__ __forceinline__ int ktiles(const pg8::Gemm& g, const pg8::Unit&) const { return g.K / pg8::BK; }
};
struct OrderUv : pg8::OrderMN {
    __device__ __forceinline__ const char* aptr(const pg8::Gemm& g, const pg8::Unit& u) const { return (const char*)(g.A + (size_t)u.pm * 256 * g.lda + (size_t)u.pn * 512); }
};

struct Ctx {
    float* out; unsigned char* ws; LAS unsigned char* lds; int G, bid, wv;
    __device__ __forceinline__ const float* in(int i) const { int z = 0; asm volatile("" : "+s"(z));
        const void* const __attribute__((address_space(4)))* ka = (const void* const __attribute__((address_space(4)))*)__builtin_amdgcn_kernarg_segment_ptr(); return (const float*)ka[i + z]; }
    template <class T> __device__ __forceinline__ T* wsp(size_t off) const { return (T*)(ws + off); }
    __device__ __forceinline__ float* ss(int i) const { return (float*)(ws + WS_SS) + (size_t)i * MPAD; }
};

__device__ __forceinline__ int rope_perm(int e) { return (e & 1) ? 32 + (e >> 1) : (e >> 1); }

__device__ __forceinline__ void conv_sub(const Ctx& c, const float* src, int ld, const float* gain, int K, bf16_t* dst, int lddst, int N, int mode, int first, int stride) {
    PH_IDS;
    constexpr int LDT = 132;
    LAS bf16_t* T = (LAS bf16_t*)c.lds;
    const int tk = K / 128, tn = N / 128, ntile = tk * tn;
    const int nl0 = tid_ & 127, kq = tid_ >> 7;
    for (int tile = first; tile < ntile; tile += stride) {
        const int k0 = (tile % tk) * 128, n0 = (tile / tk) * 128;
        int col0 = n0;
        if (mode == 1) { const int pn = n0 >> 8, r = n0 & 255; col0 = r < 128 ? pn * 128 + r : DFF + pn * 128 + (r - 128); }
        int nl = nl0;
        if (mode == 3) { const int cN = n0 + nl0, hh = cN / 192, e = cN - hh * 192; if (e >= 128) { const int rho = e - 128; nl = hh * 192 + 128 + (rho < 32 ? 2 * rho : 2 * (rho - 32) + 1) - n0; } }
        const float* sp = src + (size_t)(k0 + 32 * kq) * ld + col0 + nl0;
        float v[32];
#pragma unroll
        for (int i = 0; i < 32; ++i) v[i] = sp[(size_t)i * ld];
        if (gain) {
#pragma unroll
            for (int i = 0; i < 32; i += 4) { const f32x4 g4 = *(const f32x4*)(gain + k0 + 32 * kq + i); v[i] *= g4[0]; v[i + 1] *= g4[1]; v[i + 2] *= g4[2]; v[i + 3] *= g4[3]; } }
#pragma unroll
        for (int i = 0; i < 32; i += 4) { u32x2 w; w.x = cvt_pk_bf16(v[i], v[i + 1]); w.y = cvt_pk_bf16(v[i + 2], v[i + 3]); *(LAS u32x2*)(T + nl * LDT + 32 * kq + i) = w; }
        __syncthreads();
        { const int n = tid_ >> 2, part = tid_ & 3; int koff = k0; if (mode == 2) koff += ((n0 >> 7) & 1) * 256;
            bf16_t* drow = dst + (size_t)((mode == 4 || mode == 5) ? (n0 >> 7) * 256 + (mode == 5 ? 128 : 0) + n : n0 + n) * lddst;
#pragma unroll
            for (int q = 0; q < 4; ++q) { const LAS u32x2* tp = (const LAS u32x2*)(T + n * LDT + part * 32 + q * 8); const u32x2 lo = tp[0], hi = tp[1];
                *(u32x4*)(drow + koff + part * 32 + q * 8) = (u32x4){lo.x, lo.y, hi.x, hi.y};
                if (mode == 2) *(u32x4*)(drow + (koff ^ 256) + part * 32 + q * 8) = (u32x4){0u, 0u, 0u, 0u}; } }
        __syncthreads();
    }
}
__device__ __forceinline__ void conv_t(const Ctx& c, const float* src, int ld, const float* gain, int K, bf16_t* dst, int lddst, int N, int mode, int& rr) {
    conv_sub(c, src, ld, gain, K, dst, lddst, N, mode, (c.bid + rr) % c.G, c.G); rr += (K / 128) * (N / 128);
}
__device__ __forceinline__ void conv_sgu_w(const Ctx& c, int l, int first, int stride) {
    conv_sub(c, c.in(6) + (size_t)l * D * 4096, 4096, c.in(5) + l * D, D, c.wsp<bf16_t>(WS_W1) + (size_t)l * 4096 * D, D, 4096, 0, first, stride);
    conv_sub(c, c.in(10) + (size_t)l * DSGU * D, D, nullptr, DSGU, c.wsp<bf16_t>(WS_W3) + (size_t)l * D * DSGU, DSGU, D, 0, first, stride);
}
__device__ __forceinline__ void conv_ffn_w(const Ctx& c, int l, int first, int stride) {
    conv_sub(c, c.in(12) + (size_t)l * D * 2 * DFF, 2 * DFF, c.in(11) + l * D, D, c.wsp<bf16_t>(WS_W4) + (size_t)l * 2 * DFF * D, D, 2 * DFF, 1, first, stride);
    conv_sub(c, c.in(13) + (size_t)l * DFF * D, D, nullptr, DFF, c.wsp<bf16_t>(WS_W5) + (size_t)l * D * DFF, DFF, D, 0, first, stride);
}

__device__ __forceinline__ void phase_prologue(const Ctx& c) {
    PH_IDS;
    const int gtid = c.bid * 512 + tid_, gsz = c.G * 512;
    { f32x2* tab = c.wsp<f32x2>(WS_ROPE);
      for (int e = gtid; e < 2049 * 32; e += gsz) { const int pi = e >> 5, i = e & 31; const double pos = pi < SEQ ? (double)pi : 8192.0;
          double inv = 1.0; for (int k = 0; k < i; ++k) inv *= 0.7498942093324559;
          double x = pos * inv; x -= 6.283185307179586 * __builtin_rint(x * 0.15915494309189535);
          const double x2 = x * x; double sn = 0.0, cs = 0.0;
          { double t = x, s = t; for (int k = 1; k <= 12; ++k) { t *= -x2 / (double)((2 * k) * (2 * k + 1)); s += t; } sn = s; }
          { double t = 1.0, s = t; for (int k = 1; k <= 12; ++k) { t *= -x2 / (double)((2 * k - 1) * (2 * k)); s += t; } cs = s; }
          tab[e] = (f32x2){(float)cs, (float)sn}; } }
    { bf16_t* Hb = c.wsp<bf16_t>(WS_HB); float* ss0 = c.ss(0);
      for (int row = c.bid * 8 + wave_; row < MT; row += c.G * 8) { const float* src = row < MP ? c.in(0) + (size_t)row * D : c.in(1) + (size_t)(row - MP) * D; float sq = 0.f;
#pragma unroll
          for (int i = 0; i < 4; ++i) { const int col = i * 256 + lane_ * 4; const f32x4 v = *(const f32x4*)(src + col); sq += rsum4(v);
              u32x2 w; w.x = cvt_pk_bf16(v[0], v[1]); w.y = cvt_pk_bf16(v[2], v[3]); *(u32x2*)(Hb + (size_t)row * D + col) = w; }
#pragma unroll
          for (int o = 32; o >= 1; o >>= 1) sq += shfl_xor_l(sq, o, lane_);
          if (lane_ == 0) ss0[row] = sq; } }
    conv_sgu_w(c, 0, c.bid, c.G); conv_ffn_w(c, 0, (c.bid + 128) % c.G, c.G);
}
#define CONV_F(src, ld, gain, K, dst, lddst, N, mode) do { conv_sub(c, src, ld, gain, K, dst, lddst, N, mode, (p + rr) % np, np); rr += ((K) / 128) * ((N) / 128); } while (0)
__device__ __forceinline__ void fill_wo(const Ctx& c, int p, int np) { int rr = 0;
    for (int j = 0; j < 2; ++j) CONV_F(c.in(22) + (size_t)j * 2048 * D, D, nullptr, 2048, c.wsp<bf16_t>(WS_WO) + (size_t)j * D * 2048, 2048, D, 0);
}
__device__ __forceinline__ void fill_q(const Ctx& c, int p, int np) { int rr = 0;
    for (int j = 0; j < 2; ++j) CONV_F(c.in(21) + (size_t)j * QLR * 3072, 3072, c.in(20) + j * QLR, QLR, c.wsp<bf16_t>(WS_WQS) + (size_t)j * 3072 * QLR, QLR, 3072, 3);
    CONV_F(c.in(17), NH * 128, nullptr, KVC, c.wsp<bf16_t>(WS_WKV2), KVC, NH * 128, 4);
    CONV_F(c.in(18), NH * 128, nullptr, KVC, c.wsp<bf16_t>(WS_WKV2), KVC, NH * 128, 5);
    CONV_F(c.in(18), NH * 128, nullptr, KVC, c.wsp<bf16_t>(WS_WUV), 512, NH * 128, 2);
}
__device__ __forceinline__ void fill_misc(const Ctx& c, int p, int np) { int rr = 0;
    PH_IDS;
    const int gtid = p * 512 + tid_, gsz = np * 512;
    CONV_F(c.in(15), QKD, c.in(14), D, c.wsp<bf16_t>(WS_WKVQ), D, KVC, 0);
    CONV_F(c.in(19), QLR, c.in(5) + 2 * D, D, c.wsp<bf16_t>(WS_WKVQ) + (size_t)QKD * D, D, QLR, 0);
    CONV_F(c.in(19) + (size_t)D * QLR, QLR, c.in(5) + 3 * D, D, c.wsp<bf16_t>(WS_WDQ1), D, QLR, 0);
    { bf16_t* W = c.wsp<bf16_t>(WS_WKVQ);
      for (int e = gtid; e < 64 * D; e += gsz) { const int n = e >> 10, k = e & 1023; W[(size_t)(KVC + n) * D + k] = (bf16_t)(cvt_pk_bf16(c.in(14)[k] * c.in(15)[(size_t)k * QKD + KVC + rope_perm(n)], 0.f) & 0xffffu); }
      for (int e = gtid; e < 64 * D; e += gsz) W[(size_t)704 * D + e] = 0;
      bf16_t* W1 = c.wsp<bf16_t>(WS_WDQ1); for (int e = gtid; e < 128 * D; e += gsz) W1[(size_t)QLR * D + e] = 0; }
    { bf16_t* WQ = c.wsp<bf16_t>(WS_WQ);
      for (int e = gtid; e < 2 * NH * 64 * QLR; e += gsz) { const int r = e % QLR, t = e / QLR, ep = t & 63, h = (t >> 6) & 15, j = t >> 10;
          const float v = c.in(20)[j * QLR + r] * c.in(21)[((size_t)j * QLR + r) * 3072 + h * 192 + 128 + rope_perm(ep)];
          WQ[((size_t)j * NQ + h * QKD + KVC + ep) * QLR + r] = (bf16_t)(cvt_pk_bf16(v, 0.f) & 0xffffu); } }
    { bf16_t* UK = c.wsp<bf16_t>(WS_UKP);
      for (int e = gtid; e < NH * 256 * 256; e += gsz) { const int d = e & 255, cc = (e >> 8) & 255, h = e >> 16;
          UK[e] = d < 128 ? (bf16_t)(cvt_pk_bf16(c.in(17)[((size_t)cc * NH + h) * 128 + d], 0.f) & 0xffffu) : (bf16_t)0; } }
    { bf16_t* UQ = c.wsp<bf16_t>(WS_UQP);
      for (int e = gtid; e < 2 * NH * 512 * 256; e += gsz) { const int d = e & 255, r = (e >> 8) & 511, h = (e >> 17) & 15, j = e >> 21;
          UQ[e] = (d < 128 && r < QLR) ? (bf16_t)(cvt_pk_bf16(c.in(20)[j * QLR + r] * c.in(21)[((size_t)j * QLR + r) * 3072 + h * 192 + d], 0.f) & 0xffffu) : (bf16_t)0; } }
}
#undef CONV_F

__device__ __forceinline__ void phase_mix(const Ctx& c, int l) {
    PH_IDS;
    bf16_t* U = c.wsp<bf16_t>(WS_U); const bf16_t* V = c.wsp<bf16_t>(WS_V); const float* vsp = c.wsp<float>(WS_SSP);
    const float* gv = c.in(7) + l * DSGU; const float* wsrc = c.in(8) + (size_t)l * 8 * 128 * 128; const float* bs = c.in(9) + l * 8 * 128;
    LAS unsigned char* lds = c.lds; constexpr int WS_OFF = 65536, RS_OFF = 98304;
    const int lane = lane_, w = wave_, h = lane >> 5, blk = (lane >> 4) & 1, q4 = (lane & 15) >> 2, p = lane & 3;
    for (int item = c.bid; item < 1024; item += c.G) {
        const int g = item & 7, cb = item >> 3; const int row0 = cb * 128;
#pragma unroll
        for (int i = 0; i < 8; ++i) { const int Gq = (i * 8 + w) * 64 + lane, s = Gq >> 5, chp = Gq & 31, ch = chp ^ ((s & 3) << 2);
            __builtin_amdgcn_global_load_lds((const unsigned*)(V + (size_t)(row0 + s) * DSGU + g * 256 + ch * 8), (LAS unsigned*)(lds + (size_t)(i * 8 + w) * 1024), 16, 0, 0); }
        if (tid_ < 128) { float a = 0.f;
#pragma unroll
            for (int k = 0; k < 8; ++k) { const f32x4 pz = *(const f32x4*)(vsp + (size_t)(row0 + tid_) * 32 + 4 * k); a += (pz[0] + pz[1]) + (pz[2] + pz[3]); }
            ((LAS float*)(lds + RS_OFF))[tid_] = rsqrtf(a * (1.0f / DSGU) + EPS); }
        __syncthreads();
        { const int t = tid_ >> 2, sq = tid_ & 3; const float* wr_ = wsrc + ((size_t)g * 128 + t) * 128 + sq * 32; const LAS float* rs = (const LAS float*)(lds + RS_OFF) + sq * 32;
#pragma unroll
            for (int k8 = 0; k8 < 4; ++k8) { const f32x4 a = *(const f32x4*)(wr_ + k8 * 8), b = *(const f32x4*)(wr_ + k8 * 8 + 4); float x[8];
#pragma unroll
                for (int j = 0; j < 4; ++j) { x[j] = a[j]; x[4 + j] = b[j]; }
#pragma unroll
                for (int j = 0; j < 8; ++j) { const int s = sq * 32 + k8 * 8 + j; x[j] = s <= t ? x[j] * rs[k8 * 8 + j] : 0.f; }
                u32x4 wv; wv.x = cvt_pk_bf16(x[0], x[1]); wv.y = cvt_pk_bf16(x[2], x[3]); wv.z = cvt_pk_bf16(x[4], x[5]); wv.w = cvt_pk_bf16(x[6], x[7]);
                *(LAS u32x4*)(lds + WS_OFF + t * 256 + (((sq * 4 + k8) ^ (t & 15)) * 16)) = wv; } }
        asm volatile("s_waitcnt vmcnt(0)" ::: "memory");
        __syncthreads();
        f32x16 acc[4];
#pragma unroll
        for (int tb = 0; tb < 4; ++tb)
#pragma unroll
            for (int r = 0; r < 16; ++r) acc[tb][r] = 0.f;
#pragma unroll
        for (int ks = 0; ks < 8; ++ks) {
            bf16x8 a;
#pragma unroll
            for (int t2 = 0; t2 < 2; ++t2) { const int s = 16 * ks + 8 * h + 4 * t2 + q4; const int ch = (4 * w + 2 * blk + (p >> 1)) ^ ((s & 3) << 2);
                const s16x4 v = __builtin_amdgcn_ds_read_tr16_b64_v4i16((LAS s16x4*)(lds + s * 512 + ch * 16 + 8 * (p & 1)));
                a[4 * t2 + 0] = v[0]; a[4 * t2 + 1] = v[1]; a[4 * t2 + 2] = v[2]; a[4 * t2 + 3] = v[3]; }
#pragma unroll
            for (int tb = 0; tb < 4; ++tb) { if (ks >= 2 * (tb + 1)) continue; const int t = 32 * tb + (lane & 31);
                const bf16x8 b = *(const LAS bf16x8*)(lds + WS_OFF + t * 256 + (((2 * ks + h) ^ (t & 15)) * 16));
                acc[tb] = __builtin_amdgcn_mfma_f32_32x32x16_bf16(a, b, acc[tb], 0, 0, 0); }
        }
#pragma unroll
        for (int tb = 0; tb < 4; ++tb) { const int t = 32 * tb + (lane & 31); const float bias = bs[g * 128 + t]; bf16_t* urow = U + (size_t)(row0 + t) * DSGU + g * 256 + 32 * w + 4 * h;
#pragma unroll
            for (int r = 0; r < 4; ++r) { const f32x4 gg = *(const f32x4*)(gv + g * 256 + 32 * w + 8 * r + 4 * h); const u32x2 uu = *(const u32x2*)(urow + 8 * r);
                const float o0 = bf_lo(uu.x) * (gg[0] * acc[tb][4 * r + 0] + bias), o1 = bf_hi(uu.x) * (gg[1] * acc[tb][4 * r + 1] + bias);
                const float o2 = bf_lo(uu.y) * (gg[2] * acc[tb][4 * r + 2] + bias), o3 = bf_hi(uu.y) * (gg[3] * acc[tb][4 * r + 3] + bias);
                u32x2 o; o.x = cvt_pk_bf16(o0, o1); o.y = cvt_pk_bf16(o2, o3); *(u32x2*)(urow + 8 * r) = o; } }
        __syncthreads();
    }
    const float* slab = c.wsp<float>(WS_SLAB2); const float* ssin = c.ss(2 * l); LAS float* Z = (LAS float*)lds;
    for (int sr = c.bid; sr < MS; sr += c.G) { const int row = MP + sr; const float rstd_h = rsqrtf(ssin[row] * (1.0f / D) + EPS);
        { const int col = tid_ * 8; f32x4 z0 = (f32x4){0.f, 0.f, 0.f, 0.f}, z1 = z0;
#pragma unroll
          for (int k = 0; k < 4; ++k) { const float* sp = slab + ((size_t)k * MS + sr) * 4096 + col; z0 += *(const f32x4*)sp; z1 += *(const f32x4*)(sp + 4); }
#pragma unroll
          for (int i = 0; i < 4; ++i) { z0[i] = gelu_tanh(z0[i] * rstd_h); z1[i] = gelu_tanh(z1[i] * rstd_h); }
          *(LAS f32x4*)(Z + col) = z0; *(LAS f32x4*)(Z + col + 4) = z1; }
        __syncthreads();
        const int col = tid_ * 4, g = col >> 8; const f32x4 uu = *(const LAS f32x4*)(Z + col), vv = *(const LAS f32x4*)(Z + DSGU + col);
        float sq = rsum4(vv);
#pragma unroll
        for (int o = 32; o >= 1; o >>= 1) sq += shfl_xor_l(sq, o, lane_);
        if (lane_ == 0) Z[4096 + wave_] = sq;
        __syncthreads();
        float av = 0.f;
#pragma unroll
        for (int k = 0; k < 8; ++k) av += Z[4096 + k];
        const float rstd = rsqrtf(av * (1.0f / DSGU) + EPS);
        const float w00 = wsrc[(size_t)g * 128 * 128], b0 = bs[g * 128]; const f32x4 gg = *(const f32x4*)(gv + col);
        const f32x4 vn = vv * rstd * gg;
        *(f32x4*)(c.out + O_SGV + ((size_t)l * MS + sr) * DSGU + col) = vn;
        u32x2 o; o.x = cvt_pk_bf16(uu[0] * (w00 * vn[0] + b0), uu[1] * (w00 * vn[1] + b0)); o.y = cvt_pk_bf16(uu[2] * (w00 * vn[2] + b0), uu[3] * (w00 * vn[3] + b0));
        *(u32x2*)(U + (size_t)row * DSGU + col) = o;
        __syncthreads(); }
}

__device__ __forceinline__ void phase_kvfin(const Ctx& c) {
    PH_IDS;
    const float* KVR = c.wsp<float>(WS_KVR); bf16_t* KVb = c.wsp<bf16_t>(WS_KVB); const float* ssp = c.wsp<float>(WS_SSP); const f32x2* rope = c.wsp<f32x2>(WS_ROPE); const float* ln = c.in(16);
    for (int row = c.bid * 8 + wave_; row < MT; row += c.G * 8) {
        const f32x4 pc = *(const f32x4*)(ssp + (size_t)row * 32); const float rstd = rsqrtf(((pc[0] + pc[1]) + (pc[2] + pc[3])) * (1.0f / KVC) + EPS); const int lane = lane_;
        const f32x4 x = *(const f32x4*)(KVR + (size_t)row * QKD + lane * 4), g4 = *(const f32x4*)(ln + lane * 4); const f32x4 y = x * rstd * g4;
        float* oc = row < MP ? c.out + O_KLP + (size_t)row * KVC : c.out + O_KLS + (size_t)(row - MP) * KVC; *(f32x4*)(oc + lane * 4) = y;
        u32x2 w; w.x = cvt_pk_bf16(y[0], y[1]); w.y = cvt_pk_bf16(y[2], y[3]); *(u32x2*)(KVb + (size_t)row * QKD + lane * 4) = w;
        if (lane < 32) { const float x1 = KVR[(size_t)row * QKD + KVC + 2 * lane], x2 = KVR[(size_t)row * QKD + KVC + 2 * lane + 1];
            const int pidx = row < MP ? (row & (SEQ - 1)) : SEQ; const f32x2 cs = rope[pidx * 32 + lane];
            const float o1 = x1 * cs.x - x2 * cs.y, o2 = x2 * cs.x + x1 * cs.y;
            float* ok = row < MP ? c.out + O_KRP + (size_t)row * RD : c.out + O_KRS + (size_t)(row - MP) * RD; ok[lane] = o1; ok[32 + lane] = o2;
            *(unsigned*)(KVb + (size_t)row * QKD + KVC + 2 * lane) = cvt_pk_bf16(o1, o2); } }
}

__device__ __forceinline__ void phase_fix(const Ctx& c, int nkc, int site) {
    PH_IDS;
    bf16_t* Hb = c.wsp<bf16_t>(WS_HB); const float* slab = c.wsp<float>(WS_SLAB); float* ss = c.ss(site);
    for (int r = c.bid * 8 + wave_; r < MS; r += c.G * 8) { float sq = 0.f;
#pragma unroll
        for (int i = 0; i < 4; ++i) { const int col = i * 256 + lane_ * 4; bf16_t* hp = Hb + (size_t)(MP + r) * D + col; const u32x2 b = *(const u32x2*)hp;
            f32x4 h = (f32x4){bf_lo(b.x), bf_hi(b.x), bf_lo(b.y), bf_hi(b.y)};
            for (int k = 0; k < nkc; ++k) h += *(const f32x4*)(slab + ((size_t)k * MS + r) * D + col);
            sq += rsum4(h);
            u32x2 w; w.x = cvt_pk_bf16(h[0], h[1]); w.y = cvt_pk_bf16(h[2], h[3]); *(u32x2*)hp = w; }
#pragma unroll
        for (int o = 32; o >= 1; o >>= 1) sq += shfl_xor_l(sq, o, lane_);
        if (lane_ == 0) ss[MP + r] = sq; }
    const float* ssp = c.wsp<float>(WS_SSP);
    for (int row = c.bid * 512 + tid_; row < MP; row += c.G * 512) { float a = 0.f;
#pragma unroll
        for (int k = 0; k < 4; ++k) { const f32x4 pz = *(const f32x4*)(ssp + (size_t)row * 32 + 4 * k); a += (pz[0] + pz[1]) + (pz[2] + pz[3]); }
        ss[row] = a; }
}

__device__ __forceinline__ void phase_final(const Ctx& c) {
    PH_IDS;
    const bf16_t* Hb = c.wsp<bf16_t>(WS_HB); const float* ssp = c.wsp<float>(WS_SSP); const float* gn = c.in(23); const float* slab = c.wsp<float>(WS_SLAB);
    for (int row = c.bid * 8 + wave_; row < MT; row += c.G * 8) {
        f32x4 h[4]; float sq = 0.f;
#pragma unroll
        for (int i = 0; i < 4; ++i) { const int col = i * 256 + lane_ * 4; const u32x2 b = *(const u32x2*)(Hb + (size_t)row * D + col); h[i] = (f32x4){bf_lo(b.x), bf_hi(b.x), bf_lo(b.y), bf_hi(b.y)};
            if (row >= MP) { for (int k = 0; k < 11; ++k) h[i] += *(const f32x4*)(slab + ((size_t)k * MS + (row - MP)) * D + col); sq += rsum4(h[i]); } }
        if (row >= MP) {
#pragma unroll
            for (int o = 32; o >= 1; o >>= 1) sq += shfl_xor_l(sq, o, lane_);
        } else {
#pragma unroll
            for (int k = 0; k < 4; ++k) { const f32x4 pz = *(const f32x4*)(ssp + (size_t)row * 32 + 4 * k); sq += (pz[0] + pz[1]) + (pz[2] + pz[3]); } }
        const float rstd = rsqrtf(sq * (1.0f / D) + EPS);
        float* o = row < MP ? c.out + O_YP + (size_t)row * D : c.out + O_YS + (size_t)(row - MP) * D;
#pragma unroll
        for (int i = 0; i < 4; ++i) { const int col = i * 256 + lane_ * 4; *(f32x4*)(o + col) = h[i] * rstd * *(const f32x4*)(gn + col); } }
}

#define AT_BAR() do { asm volatile("s_waitcnt lgkmcnt(0)" ::: "memory"); __builtin_amdgcn_s_barrier(); asm volatile("" ::: "memory"); } while (0)

__device__ __forceinline__ int kswz(int row) { return (((row >> 1) & 1) << 2) | ((row >> 2) & 3); }
__device__ __forceinline__ int vswz(int row) { return ((row & 3) << 2) | ((row >> 2) & 3); }
constexpr int A3_KB = 24576, A3_VB = 16384, A3_V0 = 2 * A3_KB;
struct A3Src { unsigned koff[3]; unsigned krope; unsigned voff[2]; };
__device__ __forceinline__ void attn3_issue(LAS unsigned char* lds, const unsigned char* ws, const A3Src& a, int t, int buf, int w) {
#pragma unroll
    for (int i = 0; i < 3; ++i) { const unsigned off = a.koff[i] + (unsigned)t * (((a.krope >> i) & 1u) ? 64u * QKD * 2u : 64u * 128u * 2u);
        __builtin_amdgcn_global_load_lds((const unsigned*)(ws + off), (LAS unsigned*)(lds + buf * A3_KB + (i * 8 + w) * 1024), 16, 0, 0); }
#pragma unroll
    for (int i = 0; i < 2; ++i)
        __builtin_amdgcn_global_load_lds((const unsigned*)(ws + (a.voff[i] + (unsigned)t * (64u * 128u * 2u))), (LAS unsigned*)(lds + A3_V0 + buf * A3_VB + (i * 8 + w) * 1024), 16, 0, 0);
}
template <int BUF>
__device__ __forceinline__ void attn3_tile(LAS unsigned char* lds, const unsigned char* ws, const A3Src& a, int t, int nt, int qw0, int w, int lane,
                                           const bf16x8 (&Qf)[12], f32x16 (&O)[4], float& mref, float& lsum) {
    const int h = lane >> 5, qr = lane & 31, blk16 = (lane >> 4) & 1, q4 = (lane & 15) >> 2, p = lane & 3;
    asm volatile("s_waitcnt vmcnt(0)" ::: "memory");
    AT_BAR();
    if (t + 1 < nt) attn3_issue(lds, ws, a, t + 1, BUF ^ 1, w);
    LAS unsigned char* kbuf = lds + BUF * A3_KB; LAS unsigned char* vbuf = lds + A3_V0 + BUF * A3_VB;
    const int sk = kswz(qr);
#pragma unroll
    for (int blk = 0; blk < 2; ++blk) {
        const int kb0 = 64 * t + 32 * blk;
        if (kb0 > qw0 + 31) break;
        f32x16 S;
#pragma unroll
        for (int r = 0; r < 16; ++r) S[r] = 0.f;
#define A3_LDK(ks) (*(const LAS bf16x8*)(kbuf + (32 * blk + qr) * 384 + (((2 * (ks) + h) ^ sk) * 16)))
        { constexpr int RD = 5; bf16x8 kf[RD];
#pragma unroll
          for (int i = 0; i < RD - 1; ++i) kf[i] = A3_LDK(i);
          __builtin_amdgcn_s_setprio(1);
#pragma unroll
          for (int ks = 0; ks < 12; ++ks) {
              if (ks + RD - 1 < 12) kf[(ks + RD - 1) % RD] = A3_LDK(ks + RD - 1);
              S = __builtin_amdgcn_mfma_f32_32x32x16_bf16(kf[ks % RD], Qf[ks], S, 0, 0, 0);
              __builtin_amdgcn_sched_barrier(0); }
          __builtin_amdgcn_s_setprio(0); }
#undef A3_LDK
        if (kb0 == qw0) {
#pragma unroll
            for (int r = 0; r < 16; ++r) { const int key = (r & 3) + 8 * (r >> 2) + 4 * h; if (key > qr) S[r] = -1e30f; }
        }
        float mx = S[0];
#pragma unroll
        for (int r = 1; r < 16; ++r) mx = fmaxf(mx, S[r]);
        mx = fmaxf(mx, shfl_xor_l(mx, 32, lane));
        if (__any(mx > mref + 8.0f)) { const float mn = fmaxf(mref, mx), alpha = fast_exp2(mref - mn);
#pragma unroll
            for (int cb = 0; cb < 4; ++cb)
#pragma unroll
                for (int r = 0; r < 16; ++r) O[cb][r] *= alpha;
            lsum *= alpha; mref = mn; }
        bf16x8 P[2];
        { float ps = 0.f; unsigned pk[8];
#pragma unroll
          for (int r = 0; r < 16; r += 2) { const float p0 = fast_exp2(S[r] - mref), p1 = fast_exp2(S[r + 1] - mref); ps += p0 + p1; pk[r >> 1] = cvt_pk_bf16(p0, p1); }
          lsum += ps;
#pragma unroll
          for (int s2 = 0; s2 < 2; ++s2) { u32x4 t4; t4.x = pk[4 * s2]; t4.y = pk[4 * s2 + 1]; t4.z = pk[4 * s2 + 2]; t4.w = pk[4 * s2 + 3]; P[s2] = __builtin_bit_cast(bf16x8, t4); } }
        { constexpr int VD = 4; bf16x8 vf[VD];
#define A3_LDV(dst, i) do { const int s_ = (i) >> 2, cb_ = (i) & 3; _Pragma("unroll") for (int t2 = 0; t2 < 2; ++t2) { const int row = 32 * blk + 16 * s_ + 8 * t2 + 4 * h + q4; \
            const int ch = (4 * cb_ + 2 * blk16 + (p >> 1)) ^ vswz(row); \
            const s16x4 v = __builtin_amdgcn_ds_read_tr16_b64_v4i16((LAS s16x4*)(vbuf + row * 256 + ch * 16 + 8 * (p & 1))); \
            dst[4 * t2 + 0] = v[0]; dst[4 * t2 + 1] = v[1]; dst[4 * t2 + 2] = v[2]; dst[4 * t2 + 3] = v[3]; } } while (0)
#pragma unroll
          for (int i = 0; i < VD - 1; ++i) A3_LDV(vf[i], i);
          __builtin_amdgcn_s_setprio(1);
#pragma unroll
          for (int i = 0; i < 8; ++i) {
              if (i + VD - 1 < 8) A3_LDV(vf[(i + VD - 1) % VD], i + VD - 1);
              O[i & 3] = __builtin_amdgcn_mfma_f32_32x32x16_bf16(vf[i % VD], P[i >> 2], O[i & 3], 0, 0, 0);
              __builtin_amdgcn_sched_barrier(0); }
          __builtin_amdgcn_s_setprio(0);
#undef A3_LDV
        }
    }
}
__device__ __forceinline__ void attn3_item(const Ctx& c, int b, int head, int qblk) {
    PH_IDS;
    const bf16_t* QH = c.wsp<bf16_t>(WS_QH); bf16_t* OV = c.wsp<bf16_t>(WS_OV);
    LAS unsigned char* lds = c.lds; const int lane = lane_, w = wave_, h = lane >> 5, qr = lane & 31;
    const int qw0 = 256 * qblk + 32 * w, nt = 4 * (qblk + 1);
    static_assert(WS_END < (size_t)4 << 30, "32-bit workspace offsets");
    const unsigned kn0 = (unsigned)(WS_KN + (size_t)(b * NH + head) * SEQ * 128 * 2), vh0 = (unsigned)(WS_VH + (size_t)(b * NH + head) * SEQ * 128 * 2), kr0 = (unsigned)(WS_KVB + ((size_t)b * SEQ * QKD + KVC) * 2);
    A3Src a; a.krope = 0u;
#pragma unroll
    for (int i = 0; i < 3; ++i) { const int Gq = (i * 8 + w) * 64 + lane, r = Gq / 24, chp = Gq - r * 24, ch = chp ^ kswz(r);
        if (ch < 16) a.koff[i] = kn0 + (unsigned)(r * 128 + ch * 8) * 2u; else { a.koff[i] = kr0 + (unsigned)(r * QKD + (ch - 16) * 8) * 2u; a.krope |= 1u << i; } }
#pragma unroll
    for (int i = 0; i < 2; ++i) { const int Gq = (i * 8 + w) * 64 + lane, r = Gq >> 4, chp = Gq & 15, ch = chp ^ vswz(r); a.voff[i] = vh0 + (unsigned)(r * 128 + ch * 8) * 2u; }
    AT_BAR();
    attn3_issue(lds, c.ws, a, 0, 0, w);
    bf16x8 Qf[12];
    { const bf16_t* qrow = QH + ((size_t)b * SEQ + qw0 + qr) * 3072 + head * 192 + 8 * h;
#pragma unroll
      for (int ks = 0; ks < 12; ++ks) Qf[ks] = *(const bf16x8*)(qrow + 16 * ks); }
    f32x16 O[4];
#pragma unroll
    for (int cb = 0; cb < 4; ++cb)
#pragma unroll
        for (int r = 0; r < 16; ++r) O[cb][r] = 0.f;
    float mref = -1e30f, lsum = 0.f;
    for (int t0 = 0; t0 < nt; t0 += 2) {
        attn3_tile<0>(lds, c.ws, a, t0, nt, qw0, w, lane, Qf, O, mref, lsum);
        attn3_tile<1>(lds, c.ws, a, t0 + 1, nt, qw0, w, lane, Qf, O, mref, lsum);
    }
    lsum += shfl_xor_l(lsum, 32, lane);
    const float inv = 1.0f / lsum;
    bf16_t* orow = OV + ((size_t)b * SEQ + qw0 + qr) * 2048 + head * 128 + 8 * h;
#pragma unroll
    for (int cb = 0; cb < 4; ++cb)
#pragma unroll
        for (int j = 0; j < 2; ++j) { u32x2 ga, gb;
            ga.x = cvt_pk_bf16(O[cb][8 * j] * inv, O[cb][8 * j + 1] * inv); ga.y = cvt_pk_bf16(O[cb][8 * j + 2] * inv, O[cb][8 * j + 3] * inv);
            gb.x = cvt_pk_bf16(O[cb][8 * j + 4] * inv, O[cb][8 * j + 5] * inv); gb.y = cvt_pk_bf16(O[cb][8 * j + 6] * inv, O[cb][8 * j + 7] * inv);
            { const auto r = __builtin_amdgcn_permlane32_swap(ga.x, gb.x, false, false); ga.x = r[0]; gb.x = r[1]; }
            { const auto r = __builtin_amdgcn_permlane32_swap(ga.y, gb.y, false, false); ga.y = r[0]; gb.y = r[1]; }
            *(u32x4*)(orow + 32 * cb + 16 * j) = (u32x4){ga.x, ga.y, gb.x, gb.y}; }
}

__device__ __forceinline__ void attn_pair(const Ctx& c, int pr) {
    const int b = pr & 7, head = (pr >> 3) & 15, x = pr >> 7;
    for (int k = 0; k < 2; ++k) attn3_item(c, b, head, k ? x : 7 - x);
}

template <int SUB, int PASS> __device__ __forceinline__ void dec_load_half(f32x4 (&R)[12], const float* const (&pkv)[4], const float* const (&pkr)[4], const unsigned char* cp, int hh, int hd, int g, int lane) {
    const int tt = hh >> 1, pi = tt >> 3, key0 = (tt & 7) * 16;
    const float* kc = (pi == 0 ? pkv[0] : pi == 1 ? pkv[1] : pi == 2 ? pkv[2] : pkv[3]) + (size_t)(key0 + 8 * SUB) * KVC + 4 * lane;
#pragma unroll
    for (int r = 0; r < 8; ++r) R[r] = *((const f32x4*)(kc + r * KVC));
    if (SUB == 1) {
        const float* kr = (pi == 0 ? pkr[0] : pi == 1 ? pkr[1] : pi == 2 ? pkr[2] : pkr[3]) + (size_t)(key0 + hd) * RD + 8 * g;
        R[8] = *((const f32x4*)kr); R[9] = *((const f32x4*)(kr + 4)); R[10] = *((const f32x4*)(kr + 32)); R[11] = *((const f32x4*)(kr + 36));
    }
}
template <int T, int sub, int PASS> __device__ __forceinline__ void dec_compute_half(const f32x4 (&R)[12], f32x4 (&S)[2], LAS unsigned char* vt, const LAS unsigned char* qs, unsigned char* cp, int tt, int hd, int g, int lane) {
#pragma unroll
    for (int r = 0; r < 8; ++r) { const int row = 16 * T + 8 * sub + r; const f32x4 x = R[r];
        u32x2 w; w.x = cvt_pk_bf16(x[0], x[1]); w.y = cvt_pk_bf16(x[2], x[3]);
        *(LAS u32x2*)(vt + row * 512 + (((lane >> 1) ^ ((row & 7) << 1)) * 16) + 8 * (lane & 1)) = w;
        if ((r & 3) == 3) __builtin_amdgcn_sched_barrier(0); }
    if (sub == 1) {
        const int vrow = 16 * T + hd; f32x4 s4 = (f32x4){0.f, 0.f, 0.f, 0.f};
#pragma unroll
        for (int ks = 0; ks < 10; ++ks) { u32x4 a4; int w0, w1;
            if (ks < 8) { a4 = *(const LAS u32x4*)(vt + vrow * 512 + (((4 * ks + g) ^ ((vrow & 7) << 1)) * 16));
                w0 = __builtin_amdgcn_cvt_pk_fp8_f32(__uint_as_float(a4.x << 16), __uint_as_float(a4.x & 0xffff0000u), 0, false);
                w0 = __builtin_amdgcn_cvt_pk_fp8_f32(__uint_as_float(a4.y << 16), __uint_as_float(a4.y & 0xffff0000u), w0, true);
                w1 = __builtin_amdgcn_cvt_pk_fp8_f32(__uint_as_float(a4.z << 16), __uint_as_float(a4.z & 0xffff0000u), 0, false);
                w1 = __builtin_amdgcn_cvt_pk_fp8_f32(__uint_as_float(a4.w << 16), __uint_as_float(a4.w & 0xffff0000u), w1, true); }
            else { const f32x4 x0 = R[8 + 2 * (ks - 8)], x1 = R[9 + 2 * (ks - 8)];
                a4.x = cvt_pk_bf16(x0[0], x0[1]); a4.y = cvt_pk_bf16(x0[2], x0[3]); a4.z = cvt_pk_bf16(x1[0], x1[1]); a4.w = cvt_pk_bf16(x1[2], x1[3]);
                w0 = __builtin_amdgcn_cvt_pk_fp8_f32(x0[0], x0[1], 0, false); w0 = __builtin_amdgcn_cvt_pk_fp8_f32(x0[2], x0[3], w0, true);
                w1 = __builtin_amdgcn_cvt_pk_fp8_f32(x1[0], x1[1], 0, false); w1 = __builtin_amdgcn_cvt_pk_fp8_f32(x1[2], x1[3], w1, true); }
            *(u32x2*)(cp + ((size_t)(tt * 10 + ks) * 512 + lane * 8)) = (u32x2){(unsigned)w0, (unsigned)w1};
            const bf16x8 qv = *(const LAS bf16x8*)(qs + ks * 1024 + lane * 16);
            s4 = __builtin_amdgcn_mfma_f32_16x16x32_bf16(__builtin_bit_cast(bf16x8, a4), qv, s4, 0, 0, 0);
            if ((ks & 1) == 1) __builtin_amdgcn_sched_barrier(0); }
        S[T] = s4;
    }
}
__device__ __forceinline__ void dec_softmax_pv(const f32x4 (&S)[2], f32x4 (&O)[16], float& mref, float& lsum, const LAS unsigned char* vt, int g, int q4, int p, int lane) {
    float mx = fmaxf(fmaxf(fmaxf(S[0][0], S[0][1]), fmaxf(S[0][2], S[0][3])), fmaxf(fmaxf(S[1][0], S[1][1]), fmaxf(S[1][2], S[1][3])));
    mx = fmaxf(mx, shfl_xor_l(mx, 16, lane)); mx = fmaxf(mx, shfl_xor_l(mx, 32, lane));
    if (__any(mx > mref + 8.0f)) { const float mn = fmaxf(mref, mx), alpha = fast_exp2(mref - mn);
#pragma unroll
        for (int cb = 0; cb < 16; ++cb) O[cb] *= alpha;
        lsum *= alpha; mref = mn; }
    float pv[8];
#pragma unroll
    for (int i = 0; i < 4; ++i) { pv[i] = fast_exp2(S[0][i] - mref); pv[4 + i] = fast_exp2(S[1][i] - mref); }
    lsum += ((pv[0] + pv[1]) + (pv[2] + pv[3])) + ((pv[4] + pv[5]) + (pv[6] + pv[7]));
    u32x4 p4; p4.x = cvt_pk_bf16(pv[0], pv[1]); p4.y = cvt_pk_bf16(pv[2], pv[3]); p4.z = cvt_pk_bf16(pv[4], pv[5]); p4.w = cvt_pk_bf16(pv[6], pv[7]);
    const bf16x8 P = __builtin_bit_cast(bf16x8, p4);
#pragma unroll
    for (int cb = 0; cb < 16; ++cb) { bf16x8 a;
#pragma unroll
        for (int t2 = 0; t2 < 2; ++t2) { const int vr = 16 * t2 + 4 * g + q4; const int ch = (2 * cb + (p >> 1)) ^ ((vr & 7) << 1);
            const s16x4 v = __builtin_amdgcn_ds_read_tr16_b64_v4i16((LAS s16x4*)(vt + vr * 512 + ch * 16 + 8 * (p & 1)));
            a[4 * t2 + 0] = v[0]; a[4 * t2 + 1] = v[1]; a[4 * t2 + 2] = v[2]; a[4 * t2 + 3] = v[3]; }
        O[cb] = __builtin_amdgcn_mfma_f32_16x16x32_bf16(a, P, O[cb], 0, 0, 0);
        if ((cb & 1) == 1) __builtin_amdgcn_sched_barrier(0); }
}

typedef float f32x2v __attribute__((ext_vector_type(2)));
__device__ __forceinline__ void dec_load_tile1(u32x2 (&R)[10], const unsigned char* cp, int tt, int lane) {
#pragma unroll
    for (int k = 0; k < 10; ++k) R[k] = *(const u32x2*)(cp + ((size_t)(tt * 10 + k) * 512 + lane * 8));
}
template <int T> __device__ __forceinline__ void dec_compute_tile1(const u32x2 (&R)[10], f32x4 (&S)[2], LAS unsigned char* vt, const LAS unsigned char* qs, int hd, int g, int lane) {
    const int vrow = 16 * T + hd; f32x4 s4 = (f32x4){0.f, 0.f, 0.f, 0.f};
#pragma unroll
    for (int ks = 0; ks < 10; ++ks) { const int wx = (int)R[ks].x, wy = (int)R[ks].y;
        const f32x2v f0 = __builtin_amdgcn_cvt_pk_f32_fp8(wx, false), f1 = __builtin_amdgcn_cvt_pk_f32_fp8(wx, true), f2 = __builtin_amdgcn_cvt_pk_f32_fp8(wy, false), f3 = __builtin_amdgcn_cvt_pk_f32_fp8(wy, true);
        u32x4 a4; a4.x = cvt_pk_bf16(f0[0], f0[1]); a4.y = cvt_pk_bf16(f1[0], f1[1]); a4.z = cvt_pk_bf16(f2[0], f2[1]); a4.w = cvt_pk_bf16(f3[0], f3[1]);
        const bf16x8 qv = *(const LAS bf16x8*)(qs + ks * 1024 + lane * 16);
        s4 = __builtin_amdgcn_mfma_f32_16x16x32_bf16(__builtin_bit_cast(bf16x8, a4), qv, s4, 0, 0, 0);
        if (ks < 8) *(LAS u32x4*)(vt + vrow * 512 + (((4 * ks + g) ^ ((vrow & 7) << 1)) * 16)) = a4;
        if ((ks & 1) == 1) __builtin_amdgcn_sched_barrier(0); }
    S[T] = s4;
}

template <int PASS> __device__ __forceinline__ void decode_item(const Ctx& c, int j, int it) {
    PH_IDS;
    const bf16_t* QF = c.wsp<bf16_t>(WS_QF); bf16_t* OL = c.wsp<bf16_t>(WS_OL); float* PO = c.wsp<float>(WS_PO); float* PML = c.wsp<float>(WS_PML);
    unsigned* cnt = c.wsp<unsigned>(WS_CNT) + j * 128; const float* ckv = c.in(2); const float* ckr = c.in(3); const int* ptab = (const int*)c.in(4);
    LAS unsigned char* lds = c.lds; const int lane = lane_, w = wave_, hd = lane & 15, g = lane >> 4, q4 = (lane & 15) >> 2, p = lane & 3;
    constexpr int DQ_OFF = 131072 + 4096;
    {
        const int seq = it >> 1, half = it & 1, row = MP + seq;
        __syncthreads();
        for (int ks = w; ks < 10; ks += 8) *(LAS u32x4*)(lds + DQ_OFF + ks * 1024 + lane * 16) = *(const u32x4*)(QF + (size_t)row * NQ + hd * QKD + 32 * ks + 8 * g);
        f32x4 O[16];
#pragma unroll
        for (int cb = 0; cb < 16; ++cb) O[cb] = (f32x4){0.f, 0.f, 0.f, 0.f};
        float mref = -1e30f, lsum = 0.f;
        LAS unsigned char* vt = lds + w * 16384; const LAS unsigned char* qs = lds + DQ_OFF;
        unsigned char* cp = c.ws + WS_KC + ((size_t)it * 8 + w) * (32 * 10 * 512);
        const float* pkv[4]; const float* pkr[4];
#pragma unroll
        for (int pi = 0; pi < 4; ++pi) { const int phys = ptab[seq * NPAGES + half * 32 + w * 4 + pi]; pkv[pi] = ckv + (size_t)phys * 128 * KVC; pkr[pi] = ckr + (size_t)phys * 128 * RD; }
        __syncthreads();
        f32x4 R0[12], R1[12]; f32x4 S[2];
        S[0] = (f32x4){0.f, 0.f, 0.f, 0.f}; S[1] = S[0];
        if (PASS == 0) {
            dec_load_half<0, PASS>(R0, pkv, pkr, cp, 0, hd, g, lane);
#define DEC_STEP(i, RC, RN) do { const int hh = h0 + (i); if (hh + 1 < 64) dec_load_half<((i) + 1) & 1, PASS>(RN, pkv, pkr, cp, hh + 1, hd, g, lane); __builtin_amdgcn_sched_barrier(0); \
            dec_compute_half<((i) >> 1) & 1, (i) & 1, PASS>(RC, S, vt, qs, cp, hh >> 1, hd, g, lane); if (((i) & 3) == 3) dec_softmax_pv(S, O, mref, lsum, vt, g, q4, p, lane); __builtin_amdgcn_sched_barrier(0); } while (0)
            for (int h0 = 0; h0 < 64; h0 += 4) { DEC_STEP(0, R0, R1); DEC_STEP(1, R1, R0); DEC_STEP(2, R0, R1); DEC_STEP(3, R1, R0); }
        } else {
            u32x2 Q0[10], Q1[10];
            dec_load_tile1(Q0, cp, 0, lane);
#define DEC_STEP1(i, RC, RN) do { const int tt = t0 + (i); if (tt + 1 < 32) dec_load_tile1(RN, cp, tt + 1, lane); __builtin_amdgcn_sched_barrier(0); \
            dec_compute_tile1<(i) & 1>(RC, S, vt, qs, hd, g, lane); if ((i) == 1) dec_softmax_pv(S, O, mref, lsum, vt, g, q4, p, lane); __builtin_amdgcn_sched_barrier(0); } while (0)
            for (int t0 = 0; t0 < 32; t0 += 2) { DEC_STEP1(0, Q0, Q1); DEC_STEP1(1, Q1, Q0); }
#undef DEC_STEP1
        }
#undef DEC_STEP
        lsum += shfl_xor_l(lsum, 16, lane); lsum += shfl_xor_l(lsum, 32, lane);
        const int tid2 = opaque_tid(c.wv), lane2 = tid2 & 63, w2 = __builtin_amdgcn_readfirstlane(tid2 >> 6), hd2 = lane2 & 15, g2 = lane2 >> 4;
        asm volatile("s_waitcnt lgkmcnt(0)" ::: "memory");
#pragma unroll
        for (int cb = 0; cb < 16; ++cb)
#pragma unroll
            for (int r = 0; r < 4; ++r) ((LAS float*)(lds + w2 * 16384))[(cb * 4 + r) * 64 + lane2] = O[cb][r];
        if (g2 == 0) *(LAS f32x2*)(lds + 131072 + (w2 * 16 + hd2) * 8) = (f32x2){mref, lsum};
        __syncthreads();
        { float mv[8], M = -1e30f;
#pragma unroll
            for (int v = 0; v < 8; ++v) { mv[v] = (*(const LAS f32x2*)(lds + 131072 + (v * 16 + hd2) * 8)).x; M = fmaxf(M, mv[v]); }
            float L = 0.f, sc[8];
#pragma unroll
            for (int v = 0; v < 8; ++v) { sc[v] = fast_exp2(mv[v] - M); L += (*(const LAS f32x2*)(lds + 131072 + (v * 16 + hd2) * 8)).y * sc[v]; }
#pragma unroll
            for (int q = 0; q < 2; ++q) { const int cb = 2 * w2 + q; f32x4 o = (f32x4){0.f, 0.f, 0.f, 0.f};
#pragma unroll
                for (int v = 0; v < 8; ++v)
#pragma unroll
                    for (int r = 0; r < 4; ++r) o[r] += ((const LAS float*)(lds + v * 16384))[(cb * 4 + r) * 64 + lane2] * sc[v];
                *(f32x4*)(PO + ((size_t)it * 16 + hd2) * KVC + 16 * cb + 4 * g2) = o; }
            if (w2 == 0 && g2 == 0) *(f32x2*)(PML + ((size_t)it * 16 + hd2) * 2) = (f32x2){M, L}; }
        asm volatile("s_waitcnt vmcnt(0)" ::: "memory");
        __syncthreads();
        LAS unsigned* flag = (LAS unsigned*)(lds + 131072 + 2048);
        if (tid2 == 0) { __builtin_amdgcn_fence(__ATOMIC_RELEASE, "agent"); asm volatile("s_waitcnt vmcnt(0)" ::: "memory");
            const unsigned old = __hip_atomic_fetch_add(cnt + seq, 1u, __ATOMIC_RELAXED, __HIP_MEMORY_SCOPE_AGENT);
            if (old == 1u) { __builtin_amdgcn_fence(__ATOMIC_ACQUIRE, "agent"); asm volatile("s_waitcnt vmcnt(0)" ::: "memory"); }
            flag[0] = old; }
        __syncthreads();
        if (flag[0] == 1u) {
            const float* cn = c.out + O_KLS + (size_t)seq * KVC; const float* kn = c.out + O_KRS + (size_t)seq * RD;
            LAS float* sself = (LAS float*)(lds + 131072 + 2304);
#pragma unroll
            for (int q = 0; q < 2; ++q) { const int hh = 2 * w2 + q; const bf16_t* qh = QF + (size_t)row * NQ + hh * QKD; float s = 0.f;
#pragma unroll
                for (int i = 0; i < 5; ++i) { const int d = lane2 + 64 * i; const float kvv = d < KVC ? cn[d] : kn[d - KVC]; s += __uint_as_float((unsigned)qh[d] << 16) * kvv; }
#pragma unroll
                for (int o = 32; o >= 1; o >>= 1) s += shfl_xor_l(s, o, lane2);
                if (lane2 == 0) sself[hh] = s; }
            __syncthreads();
            const int idx = tid2 * 8, hh = idx >> 8, cc = idx & 255; const int ia = seq * 2, ib = seq * 2 + 1;
            const f32x2 ma = *(const f32x2*)(PML + ((size_t)ia * 16 + hh) * 2), mb = *(const f32x2*)(PML + ((size_t)ib * 16 + hh) * 2); const float ssf = sself[hh];
            const float M = fmaxf(fmaxf(ma.x, mb.x), ssf), ea = fast_exp2(ma.x - M), eb = fast_exp2(mb.x - M), es = fast_exp2(ssf - M), inv = 1.0f / (ma.y * ea + mb.y * eb + es);
            float o[8];
#pragma unroll
            for (int q = 0; q < 2; ++q) { const f32x4 xa = *(const f32x4*)(PO + ((size_t)ia * 16 + hh) * KVC + cc + 4 * q), xb = *(const f32x4*)(PO + ((size_t)ib * 16 + hh) * KVC + cc + 4 * q), xc = *(const f32x4*)(cn + cc + 4 * q);
#pragma unroll
                for (int i = 0; i < 4; ++i) o[4 * q + i] = (xa[i] * ea + xb[i] * eb + xc[i] * es) * inv; }
            u32x4 wv; wv.x = cvt_pk_bf16(o[0], o[1]); wv.y = cvt_pk_bf16(o[2], o[3]); wv.z = cvt_pk_bf16(o[4], o[5]); wv.w = cvt_pk_bf16(o[6], o[7]);
            *(u32x4*)(OL + (size_t)row * 4096 + hh * KVC + cc) = wv;
        }
    }
}

template <int PASS> __device__ __forceinline__ void phase_attn(const Ctx& c, int j) {
    if (c.G == 256) {
        const int b = c.bid & 7, k = (c.bid >> 3) & 7, team = c.bid >> 6, dslot = (4 * b + team) % 3; int r = 0;
        for (int slot = 0; slot < 3; ++slot) {
            if (slot == dslot) decode_item<PASS>(c, j, c.bid);
            else { for (int e = 0; e < 2; ++e, ++r) attn3_item(c, b, 4 * team + r, (r & 1) ? 7 - k : k); }
        }
        return;
    }
    int pr = c.bid; const int dslot = (c.bid & 127) % 3;
    for (int slot = 0; slot < 3; ++slot) {
        if (slot == dslot) { for (int it = c.bid; it < 256; it += c.G) decode_item<PASS>(c, j, it); }
        else if (pr < 512) { attn_pair(c, pr); pr += c.G; }
    }
    for (; pr < 512; pr += c.G) attn_pair(c, pr);
}
__device__ __forceinline__ void phase_attn_prompt(const Ctx& c) { for (int pr = c.bid; pr < 512; pr += c.G) attn_pair(c, pr); }
__device__ __forceinline__ void phase_attn_decode(const Ctx& c, int j) { for (int it = c.bid; it < 256; it += c.G) decode_item<0>(c, j, it); }

struct Args { const void* in[24]; float* out; unsigned char* ws; int ph_lo, ph_hi; };
enum { K_KVUP = 50, K_PRO = 0, K_ABS, K_SGU, K_MIX, K_RES_SGU, K_FFN_IN, K_FFN_OUT, K_KVQ, K_KVFIN, K_DQ1, K_Q, K_ATTN, K_UV, K_WO, K_FINAL, K_FIX_MID, K_FIX_OUT, K_ATTN_P, K_ATTN_D };

template <int KIND> __device__ __forceinline__ void run_phase(const Ctx& c, int l) {
    LAS unsigned char* lds = c.lds; bf16_t* Hb = c.wsp<bf16_t>(WS_HB);
    const int j = l - 2, s_in = 2 * l, s_mid = 2 * l + 1, s_out = 2 * l + 2;
    if constexpr (KIND == K_PRO) phase_prologue(c);
    if constexpr (KIND == K_ABS) { pg8::Gemm g{c.wsp<bf16_t>(WS_UKP), c.wsp<bf16_t>(WS_UQP), 256, 256, 256}; OrderAbs S{c.G, c.bid}; EpiAbs E{c.wsp<bf16_t>(WS_WQ)}; pg8::gemm_phase(lds, g, S, E, c.wv); }
    if constexpr (KIND == K_SGU) { pg8::Gemm g{Hb, c.wsp<bf16_t>(WS_W1) + (size_t)l * 4096 * D, D, D, D}; OrderRes S; S.init(16, D / 256, c.G, c.bid);
        EpiSgu E{c.ss(s_in), c.wsp<bf16_t>(WS_U), c.wsp<bf16_t>(WS_V), c.wsp<float>(WS_SSP), c.wsp<float>(WS_SLAB2)}; pg8::gemm_phase(lds, g, S, E, c.wv); }
    if constexpr (KIND == K_MIX) phase_mix(c, l);
    if constexpr (KIND == K_RES_SGU) { pg8::Gemm g{c.wsp<bf16_t>(WS_U), c.wsp<bf16_t>(WS_W3) + (size_t)l * D * DSGU, DSGU, DSGU, DSGU}; OrderRes S; S.init(4, DSGU / 256, c.G, c.bid);
        EpiRes E{Hb, c.wsp<float>(WS_SSP), c.wsp<float>(WS_SLAB), Hb}; pg8::gemm_phase(lds, g, S, E, c.wv);
        { const int F = c.G > 32 ? 32 : 0; if (c.bid >= F) { if (l == 0) fill_wo(c, c.bid - F, c.G - F); else fill_q(c, c.bid - F, c.G - F); } } }
    if constexpr (KIND == K_FIX_MID) phase_fix(c, l < 2 ? DSGU / 256 : 2048 / 256, s_mid);
    if constexpr (KIND == K_FIX_OUT) phase_fix(c, DFF / 256, s_out);
    if constexpr (KIND == K_FFN_IN) { pg8::Gemm g{Hb, c.wsp<bf16_t>(WS_W4) + (size_t)l * 2 * DFF * D, D, D, D}; pg8::OrderMN S; S.init(NPAN, 22, c.G, c.bid);
        EpiFfn E{c.ss(s_mid), c.wsp<bf16_t>(WS_F)}; pg8::gemm_phase(lds, g, S, E, c.wv);
        { const int F = c.G > 150 ? 150 : 0; if (l < 3 && c.bid >= F) conv_ffn_w(c, l + 1, c.bid - F, c.G - F); } }
    if constexpr (KIND == K_FFN_OUT) { pg8::Gemm g{c.wsp<bf16_t>(WS_F), c.wsp<bf16_t>(WS_W5) + (size_t)l * D * DFF, DFF, DFF, DFF}; OrderRes S; S.init(4, DFF / 256, c.G, c.bid);
        EpiRes E{Hb, c.wsp<float>(WS_SSP), c.wsp<float>(WS_SLAB), Hb}; pg8::gemm_phase(lds, g, S, E, c.wv);
        { const int F = c.G > 44 ? 44 : 0; if (c.bid >= F) { if (l == 0) conv_sgu_w(c, 1, c.bid - F, c.G - F); else if (l == 1) fill_misc(c, c.bid - F, c.G - F); } } }
    if constexpr (KIND == K_KVQ) { { pg8::Gemm g{Hb, c.wsp<bf16_t>(WS_WKVQ), D, D, D}; pg8::OrderMN S; S.init(NPAN, 3, c.G, c.bid);
        EpiKvq E{c.ss(s_in), c.wsp<float>(WS_KVR), c.wsp<float>(WS_SSP), c.wsp<bf16_t>(WS_CQ), KVC, QKD, QKD + QLR}; pg8::gemm_phase(lds, g, S, E, c.wv); }
        { pg8::Gemm g{c.wsp<bf16_t>(WS_UKP), c.wsp<bf16_t>(WS_UQP), 256, 256, 256}; OrderAbs S{c.G, c.G - 1 - c.bid}; EpiAbs E{c.wsp<bf16_t>(WS_WQ)}; pg8::gemm_phase(lds, g, S, E, c.wv); } }
    if constexpr (KIND == K_KVFIN) phase_kvfin(c);
    if constexpr (KIND == K_DQ1) { pg8::Gemm g{Hb, c.wsp<bf16_t>(WS_WDQ1), D, D, D}; pg8::OrderMN S; S.init(NPAN, 2, c.G, c.bid);
        EpiKvq E{c.ss(s_in), c.wsp<float>(WS_KVR), c.wsp<float>(WS_SSP), c.wsp<bf16_t>(WS_CQ), 0, 0, QLR}; pg8::gemm_phase(lds, g, S, E, c.wv); }
    if constexpr (KIND == K_Q) { if (j == 0) phase_kvfin(c);
        pg8::Gemm g{c.wsp<bf16_t>(WS_CQ), c.wsp<bf16_t>(WS_WQS) + (size_t)j * 3072 * QLR, QLR, QLR, QLR}; OrderQ2 S; S.init(c.wsp<bf16_t>(WS_WQ) + (size_t)j * NQ * QLR, c.G, c.bid);
        EpiQ E{c.wsp<float>(WS_SSP), c.wsp<bf16_t>(WS_QF), c.wsp<f32x2>(WS_ROPE), c.wsp<bf16_t>(WS_QH)}; pg8::gemm_phase(lds, g, S, E, c.wv); }
    if constexpr (KIND == K_KVUP) { pg8::Gemm g{c.wsp<bf16_t>(WS_KVB), c.wsp<bf16_t>(WS_WKV2), QKD, KVC, KVC}; pg8::OrderMN S; S.init(64, 16, c.G, c.bid);
        EpiKvup E{c.wsp<bf16_t>(WS_KN), c.wsp<bf16_t>(WS_VH)}; pg8::gemm_phase(lds, g, S, E, c.wv); }
    if constexpr (KIND == K_ATTN) { if (j == 0) phase_attn<0>(c, j); else phase_attn<1>(c, j); }
    if constexpr (KIND == K_ATTN_P) phase_attn_prompt(c);
    if constexpr (KIND == K_ATTN_D) phase_attn_decode(c, j);
    if constexpr (KIND == K_UV) { pg8::Gemm g{c.wsp<bf16_t>(WS_OL), c.wsp<bf16_t>(WS_WUV), 4096, 512, 512}; OrderUvS S{c.G, c.bid};
        EpiPlain E{c.wsp<bf16_t>(WS_OV), 2048}; pg8::gemm_phase(lds, g, S, E, c.wv); }
    if constexpr (KIND == K_WO) { pg8::Gemm g{c.wsp<bf16_t>(WS_OV), c.wsp<bf16_t>(WS_WO) + (size_t)j * D * 2048, 2048, 2048, 2048}; OrderRes S; S.init(4, 2048 / 256, c.G, c.bid);
        EpiRes E{Hb, c.wsp<float>(WS_SSP), c.wsp<float>(WS_SLAB), Hb}; pg8::gemm_phase(lds, g, S, E, c.wv); }
    if constexpr (KIND == K_FINAL) phase_final(c);
}

constexpr int N_PHASES = 34;
struct Prog { int kind[N_PHASES]; int layer[N_PHASES]; };
__host__ __device__ constexpr Prog make_prog() {
    Prog p{}; int n = 0;
    p.kind[n] = K_PRO; p.layer[n++] = 0;
    for (int l = 0; l < 4; ++l) {
        if (l < 2) { const int ks[4] = {K_SGU, K_MIX, K_RES_SGU, K_FIX_MID}; for (int i = 0; i < 4; ++i) { p.kind[n] = ks[i]; p.layer[n++] = l; } }
        else { if (l == 2) { p.kind[n] = K_KVQ; p.layer[n++] = l; } else { p.kind[n] = K_DQ1; p.layer[n++] = l; }
            p.kind[n] = K_Q; p.layer[n++] = l; if (l == 2) { p.kind[n] = K_KVUP; p.layer[n++] = l; }
            const int ks[4] = {K_ATTN, K_UV, K_WO, K_FIX_MID}; for (int i = 0; i < 4; ++i) { p.kind[n] = ks[i]; p.layer[n++] = l; } }
        p.kind[n] = K_FFN_IN; p.layer[n++] = l; p.kind[n] = K_FFN_OUT; p.layer[n++] = l;
        if (l < 3) { p.kind[n] = K_FIX_OUT; p.layer[n++] = l; }
    }
    p.kind[n] = K_FINAL; p.layer[n++] = 3;
    return p;
}
constexpr Prog PROG = make_prog();
__host__ __device__ constexpr int prog_kind(int p) { return PROG.kind[p]; }
__host__ __device__ constexpr int prog_layer(int p) { return PROG.layer[p]; }
static_assert(PROG.kind[N_PHASES - 1] == K_FINAL, "phase count");

__device__ __forceinline__ void make_ctx(Ctx& c, const Args& args, unsigned char* lds_raw) {
    c.out = args.out; c.ws = args.ws; c.lds = (LAS unsigned char*)lds_raw; c.G = gridDim.x; c.bid = blockIdx.x; c.wv = __builtin_amdgcn_readfirstlane((int)threadIdx.x >> 6);
}

template <int KIND> __global__ void __launch_bounds__(512, 2) k_phase(Args args) {
    extern __shared__ __attribute__((aligned(16))) unsigned char lds_raw[];
    Ctx c; make_ctx(c, args, lds_raw);
    run_phase<KIND>(c, args.ph_lo);
}

#if MK_LAUNCHES == 1
template <int P> __device__ __forceinline__ void run_all(const Ctx& c, const XcdBarrier& bar) {
    if constexpr (P < N_PHASES) {
        run_phase<prog_kind(P)>(c, prog_layer(P));
#ifdef PROBE_DUP
        if constexpr (prog_kind(P) == PROBE_DUP) { xcd_barrier(bar); run_phase<PROBE_DUP_AS>(c, prog_layer(P)); }
#endif
        if constexpr (P + 1 < N_PHASES) xcd_barrier(bar);
        run_all<P + 1>(c, bar);
    }
}
__global__ void __launch_bounds__(512, 2) fwd_kernel(Args args) {
    extern __shared__ __attribute__((aligned(16))) unsigned char lds_raw[];
    Ctx c; make_ctx(c, args, lds_raw);
    LAS unsigned char* lds = c.lds;
    if (threadIdx.x < 4) ((LAS unsigned*)(lds + LDS_MISC))[threadIdx.x] = 0u;
    __syncthreads();
    const XcdBarrier bar = xcd_barrier_post((unsigned*)(args.ws + WS_BAR), (volatile LAS unsigned*)(lds + LDS_MISC));
    run_all<0>(c, bar);
}
#endif

template <int KIND> static void launch_kind(int grid, hipStream_t stream, Args a, int l) {
    static bool set = false;
    if (!set) { (void)hipFuncSetAttribute((const void*)k_phase<KIND>, hipFuncAttributeMaxDynamicSharedMemorySize, LDS_BYTES); set = true; }
    a.ph_lo = l; a.ph_hi = 0;
    hipLaunchKernelGGL(k_phase<KIND>, dim3(grid), dim3(512), LDS_BYTES, stream, a);
}
template <int P> static void launch_all(int grid, hipStream_t stream, const Args& a) {
    if constexpr (P < N_PHASES) { launch_kind<prog_kind(P)>(grid, stream, a, prog_layer(P)); launch_all<P + 1>(grid, stream, a); }
}

extern "C" void kernel_launch(void* const* d_in, const int* in_sizes, int n_in, void* d_out, int out_size, void* d_ws, size_t ws_size, hipStream_t stream) {
    static int grid = 0;
    if (grid == 0) {
        if (n_in != 24 || ws_size < WS_END) { fprintf(stderr, "kernel_launch: unexpected inputs (n_in %d, ws %zu < %zu)\n", n_in, ws_size, (size_t)WS_END); grid = -1; return; }
        int dev = 0, cus = 0, per_cu = 0;
        if (hipGetDevice(&dev) != hipSuccess || hipDeviceGetAttribute(&cus, hipDeviceAttributeMultiprocessorCount, dev) != hipSuccess) { grid = -1; return; }
#if MK_LAUNCHES == 1
        if (hipFuncSetAttribute((const void*)fwd_kernel, hipFuncAttributeMaxDynamicSharedMemorySize, LDS_BYTES) != hipSuccess) { fprintf(stderr, "kernel_launch: hipFuncSetAttribute failed\n"); grid = -1; return; }
        if (hipOccupancyMaxActiveBlocksPerMultiprocessor(&per_cu, (const void*)fwd_kernel, 512, LDS_BYTES) != hipSuccess || per_cu < 1) { fprintf(stderr, "kernel_launch: occupancy query says %d\n", per_cu); (void)hipGetLastError(); }
#endif
        (void)per_cu;
        grid = cus;
    }
    if (grid < 0) return;
    (void)hipMemsetAsync(d_ws, 0, WS_SS, stream);
    Args a{};
    for (int i = 0; i < 24; ++i) a.in[i] = d_in[i];
    a.out = (float*)d_out; a.ws = (unsigned char*)d_ws;
#if MK_LAUNCHES == 1
    a.ph_lo = 0; a.ph_hi = N_PHASES;
    hipLaunchKernelGGL(fwd_kernel, dim3(grid), dim3(512), LDS_BYTES, stream, a);
#else
    launch_all<0>(grid, stream, a);
#endif
}
```
